# Optimizing an MI355X kernel written in HIP

```python
import math
import jax
import jax.numpy as jnp
from jax import lax
import numpy as np

D_MODEL = 1024
BATCH = 8
SEQ = 8192
DEPTH = 2

GRID_W = 64
N_BRANCHES = 4
BRANCH_W = D_MODEL // N_BRANCHES
HEAD_DIM = 64
N_Q_HEADS = BRANCH_W // HEAD_DIM
N_KV_HEADS = 2
Q_GROUP = N_Q_HEADS // N_KV_HEADS
ROPE_HALF = HEAD_DIM // 2
ROPE_THETA = 10000.0
Q_BLOCK = 128
SC_WIDTH = 3
CF_WIDTH = 31
POOL_WINDOWS = (2, 4, 8, 16)
POOL_GROUP = BRANCH_W // len(POOL_WINDOWS)
N_EXPERTS = 32
TOP_K = 4
D_EXPERT = D_MODEL
SWIGLU_LIMIT = 7.0
SWIGLU_ALPHA = 1.702
MOE_BLOCK = 256
DN_ALPHA = (2.0 * DEPTH) ** 0.25
DN_BETA = (8.0 * DEPTH) ** -0.25
LN_EPS = 1e-5
RMS_EPS = 1e-6

Q_COLS = N_Q_HEADS * HEAD_DIM
KV_COLS = N_KV_HEADS * HEAD_DIM
IN_SIZES = (Q_COLS, KV_COLS, KV_COLS, 3 * BRANCH_W, 2 * BRANCH_W, BRANCH_W, N_BRANCHES * D_MODEL)
IN_COLS = sum(IN_SIZES)
IN_SPLITS = [int(s) for s in np.cumsum(IN_SIZES)[:-1]]

kernel_name = "hybrid_gated_branch_encoder"


def layer_norm(x, g, b):
    xf = x.astype(jnp.float32)
    mu = jnp.mean(xf, axis=-1, keepdims=True)
    var = jnp.mean(jnp.square(xf - mu), axis=-1, keepdims=True)
    return ((xf - mu) * lax.rsqrt(var + LN_EPS) * g + b).astype(x.dtype)


def rms_norm_f32(x, g):
    xf = x.astype(jnp.float32)
    return xf * lax.rsqrt(jnp.mean(jnp.square(xf), axis=-1, keepdims=True) + RMS_EPS) * g


def axial_rope_tables(seq):
    rows = seq // GRID_W
    row = jnp.repeat(jnp.arange(rows, dtype=jnp.float32), GRID_W)
    col = jnp.tile(jnp.arange(GRID_W, dtype=jnp.float32), rows)
    inv = ROPE_THETA ** (-jnp.arange(0, ROPE_HALF, 2, dtype=jnp.float32) / ROPE_HALF)
    ang_r = row[:, None] * inv
    ang_c = col[:, None] * inv
    return (jnp.cos(ang_r), jnp.sin(ang_r), jnp.cos(ang_c), jnp.sin(ang_c))


def apply_axial_rope(x, tabs):
    cr, sr, cc, sc = (t[:, None, :] for t in tabs)
    r1, r2, c1, c2 = jnp.split(x, 4, axis=-1)
    return jnp.concatenate([r1 * cr - r2 * sr, r2 * cr + r1 * sr,
                            c1 * cc - c2 * sc, c2 * cc + c1 * sc], axis=-1)


def gqa_attention(zq, zk, zv, q_gain, k_gain, tabs):
    B, S, _ = zq.shape
    dt = zq.dtype
    q = apply_axial_rope(rms_norm_f32(zq.reshape(B, S, N_Q_HEADS, HEAD_DIM), q_gain), tabs) * (HEAD_DIM ** -0.5)
    k = apply_axial_rope(rms_norm_f32(zk.reshape(B, S, N_KV_HEADS, HEAD_DIM), k_gain), tabs).astype(dt)
    v = zv.reshape(B, S, N_KV_HEADS, HEAD_DIM)
    q = q.astype(dt).reshape(B, S // Q_BLOCK, Q_BLOCK, N_KV_HEADS, Q_GROUP, HEAD_DIM)
    q = jnp.moveaxis(q, 1, 0)

    def block(qb):
        s = jnp.einsum('bqkgd,bskd->bkgqs', qb, k, preferred_element_type=jnp.float32)
        p = jax.nn.softmax(s, axis=-1).astype(dt)
        return jnp.einsum('bkgqs,bskd->bqkgd', p, v)

    o = lax.map(block, q)
    return jnp.moveaxis(o, 0, 1).reshape(B, S, N_Q_HEADS * HEAD_DIM)


def depthwise_conv(x, w):
    K, C = w.shape
    return lax.conv_general_dilated(x, w[:, None, :].astype(x.dtype), window_strides=(1,),
                                    padding=[(K // 2, K // 2)],
                                    dimension_numbers=('NWC', 'WIO', 'NWC'),
                                    feature_group_count=C)


def short_gated_conv(z, conv_w):
    b_gate, c_gate, u = jnp.split(z, 3, axis=-1)
    return b_gate * depthwise_conv(c_gate * u, conv_w)


def conformer_conv(z, conv_w, conv_b, ln_g, ln_b):
    a, g = jnp.split(z, 2, axis=-1)
    y = depthwise_conv(a * jax.nn.sigmoid(g), conv_w) + conv_b
    return jax.nn.silu(layer_norm(y, ln_g, ln_b))


def multiscale_pool(u, pool_w, pool_scale):
    B, S, W = u.shape
    uf = u.astype(jnp.float32)
    csum = jnp.pad(jnp.cumsum(uf, axis=1), ((0, 0), (1, 0), (0, 0)))
    t = jnp.arange(S)
    outs = []
    for i, w in enumerate(POOL_WINDOWS):
        lo = jnp.maximum(t - w // 2, 0)
        hi = jnp.minimum(t + (w - 1 - w // 2), S - 1)
        sl = slice(i * POOL_GROUP, (i + 1) * POOL_GROUP)
        c = csum[:, :, sl]
        mean = (c[:, hi + 1] - c[:, lo]) / (hi - lo + 1).astype(jnp.float32)[:, None]
        outs.append(mean - uf[:, :, sl])
    y = jnp.stack(outs, axis=2).astype(u.dtype)
    y = jnp.einsum('bsgc,gcd->bsgd', y, pool_w).reshape(B, S, W)
    return y * pool_scale


def token_mixer(x, w_in, b_in, q_g, k_g, sc_w, cf_w, cf_b, cf_g, cf_beta,
                pool_w, pool_scale, w_branch, w_out, tabs):
    B, S, D = x.shape
    z = x @ w_in + b_in
    zq, zk, zv, zsc, zcf, zpool, zgate = jnp.split(z, IN_SPLITS, axis=-1)
    branches = jnp.stack([
        gqa_attention(zq, zk, zv, q_g, k_g, tabs),
        short_gated_conv(zsc, sc_w),
        conformer_conv(zcf, cf_w, cf_b, cf_g, cf_beta),
        multiscale_pool(zpool, pool_w, pool_scale),
    ], axis=2)
    proj = jnp.einsum('bsgc,gcd->bsgd', branches, w_branch)
    gates = jax.nn.sigmoid(zgate.reshape(B, S, N_BRANCHES, D))
    merged = jnp.sum(gates * proj, axis=2)
    return merged @ w_out


def moe_ffn(x, w_router, b_router, w_gu, b_gu, w_down, b_down):
    B, S, D = x.shape
    xt = x.reshape(-1, D)
    n_tok = xt.shape[0]
    n_assign = n_tok * TOP_K
    logits = jnp.dot(xt, w_router, preferred_element_type=jnp.float32) + b_router.astype(jnp.float32)
    top_logits, top_idx = lax.top_k(logits, TOP_K)
    top_w = jax.nn.softmax(top_logits, axis=-1)
    flat_e = top_idx.reshape(-1)
    flat_tok = jnp.broadcast_to(jnp.arange(n_tok, dtype=jnp.int32)[:, None], (n_tok, TOP_K)).reshape(-1)
    order = jnp.argsort(flat_e)
    se, stok, sw = flat_e[order], flat_tok[order], top_w.reshape(-1)[order]
    counts = jnp.bincount(flat_e, length=N_EXPERTS)
    start = jnp.cumsum(counts) - counts
    padded = (counts + MOE_BLOCK - 1) // MOE_BLOCK * MOE_BLOCK
    pend = jnp.cumsum(padded)
    pstart = pend - padded
    dest = pstart[se] + jnp.arange(n_assign, dtype=jnp.int32) - start[se]
    n_slots = (n_assign + MOE_BLOCK - 1) // MOE_BLOCK * MOE_BLOCK + N_EXPERTS * MOE_BLOCK
    slot_tok = jnp.zeros((n_slots,), jnp.int32).at[dest].set(stok)
    slot_w = jnp.zeros((n_slots,), jnp.float32).at[dest].set(sw)
    n_blocks = n_slots // MOE_BLOCK
    blk_e = jnp.minimum(jnp.searchsorted(pend, jnp.arange(n_blocks) * MOE_BLOCK, side='right'),
                        N_EXPERTS - 1)

    def expert_block(args):
        tok, e = args
        h = jnp.dot(xt[tok], w_gu[e]) + b_gu[e]
        glu, lin = jnp.split(h, 2, axis=-1)
        glu = jnp.minimum(glu, SWIGLU_LIMIT)
        lin = jnp.clip(lin, -SWIGLU_LIMIT, SWIGLU_LIMIT)
        act = glu * jax.nn.sigmoid(SWIGLU_ALPHA * glu) * (lin + 1.0)
        return jnp.dot(act, w_down[e]) + b_down[e]

    y = lax.map(expert_block, (slot_tok.reshape(n_blocks, MOE_BLOCK), blk_e))
    y = y.reshape(n_slots, D).astype(jnp.float32) * slot_w[:, None]
    out = jax.ops.segment_sum(y, slot_tok, num_segments=n_tok)
    return out.astype(x.dtype).reshape(B, S, D)


def setup_inputs(seed: int = 0) -> dict:
    key = jax.random.key(seed)
    ks = jax.random.split(key, 26)
    f32 = jnp.float32

    def nrm(k, shape, scale):
        return jax.random.normal(k, shape, f32) * scale

    D, W, E, F, L = D_MODEL, BRANCH_W, N_EXPERTS, D_EXPERT, DEPTH
    return {
        "x": nrm(ks[0], (BATCH, SEQ, D), 1.0),
        "ln_in_g": 1.0 + nrm(ks[1], (D,), 0.02),
        "ln_in_b": nrm(ks[2], (D,), 0.02),
        "w_in": nrm(ks[3], (L, D, IN_COLS), D ** -0.5),
        "b_in": nrm(ks[4], (L, IN_COLS), 0.02),
        "q_norm_g": 1.0 + nrm(ks[5], (L, HEAD_DIM), 0.02),
        "k_norm_g": 1.0 + nrm(ks[6], (L, HEAD_DIM), 0.02),
        "sc_conv_w": nrm(ks[7], (L, SC_WIDTH, W), SC_WIDTH ** -0.5),
        "cf_conv_w": nrm(ks[8], (L, CF_WIDTH, W), CF_WIDTH ** -0.5),
        "cf_conv_b": nrm(ks[9], (L, W), 0.02),
        "cf_ln_g": 1.0 + nrm(ks[10], (L, W), 0.02),
        "cf_ln_b": nrm(ks[11], (L, W), 0.02),
        "pool_w": nrm(ks[12], (L, len(POOL_WINDOWS), POOL_GROUP, POOL_GROUP), POOL_GROUP ** -0.5),
        "pool_scale": 1.0 + nrm(ks[13], (L, W), 0.02),
        "w_branch": nrm(ks[14], (L, N_BRANCHES, W, D), DN_BETA * W ** -0.5),
        "w_out": nrm(ks[15], (L, D, D), DN_BETA * D ** -0.5),
        "ln1_g": 1.0 + nrm(ks[16], (L, D), 0.02),
        "ln1_b": nrm(ks[17], (L, D), 0.02),
        "w_router": nrm(ks[18], (L, D, E), D ** -0.5),
        "b_router": nrm(ks[19], (L, E), 0.01),
        "w_gate_up": nrm(ks[20], (L, E, D, 2 * F), D ** -0.5),
        "b_gate_up": nrm(ks[21], (L, E, 2 * F), 0.02),
        "w_down": nrm(ks[22], (L, E, F, D), DN_BETA * F ** -0.5),
        "b_down": nrm(ks[23], (L, E, D), 0.02),
        "ln2_g": 1.0 + nrm(ks[24], (L, D), 0.02),
        "ln2_b": nrm(ks[25], (L, D), 0.02),
    }


def reference(x, ln_in_g, ln_in_b, w_in, b_in, q_norm_g, k_norm_g, sc_conv_w, cf_conv_w,
              cf_conv_b, cf_ln_g, cf_ln_b, pool_w, pool_scale, w_branch, w_out, ln1_g, ln1_b,
              w_router, b_router, w_gate_up, b_gate_up, w_down, b_down, ln2_g, ln2_b):
    tabs = axial_rope_tables(x.shape[1])
    h = layer_norm(x, ln_in_g, ln_in_b)
    for l in range(DEPTH):
        mix = token_mixer(h, w_in[l], b_in[l], q_norm_g[l], k_norm_g[l], sc_conv_w[l],
                          cf_conv_w[l], cf_conv_b[l], cf_ln_g[l], cf_ln_b[l], pool_w[l],
                          pool_scale[l], w_branch[l], w_out[l], tabs)
        h = layer_norm(DN_ALPHA * h + mix, ln1_g[l], ln1_b[l])
        ffn = moe_ffn(h, w_router[l], b_router[l], w_gate_up[l], b_gate_up[l], w_down[l], b_down[l])
        h = layer_norm(DN_ALPHA * h + ffn, ln2_g[l], ln2_b[l])
    return h
```

```cpp
#include <hip/hip_runtime.h>
#include <cstdio>
#include <cstdint>
#include <hip/hip_runtime.h>
#include <cstdio>
#include <cstdint>
namespace pg8 {
#define PG8_LAS __attribute__((address_space(3)))
typedef unsigned short bf16_t;
typedef short bf16x8 __attribute__((ext_vector_type(8)));
typedef float f32x4 __attribute__((ext_vector_type(4)));
typedef unsigned u32x4 __attribute__((ext_vector_type(4)));
constexpr int BM = 256, BK = 64, HALF = 128, HTB = HALF * BK * 2  , STAGE_BYTES = 8 * HTB, NXCD = 8, WGM = 8;

__host__ __device__ __forceinline__ int lds_byte(int r, int c) { const int st = (r >> 4) * 2 + (c >> 5), rr = r & 15, cc = c & 31, ob = rr * 64 + cc * 2; return st * 1024 + (ob ^ (((ob >> 9) & 1) << 5)); }
__host__ __device__ __forceinline__ void stage_rc(int b, int& R, int& C) { const int st = b / 1024, sb = b % 1024, swz = sb ^ (((sb >> 9) & 1) << 5); R = (st >> 1) * 16 + swz / 64; C = (st & 1) * 32 + (swz % 64) / 2; }
__host__ __device__ __forceinline__ int perm32(int rho) { const int n = rho >> 4, i = rho & 15; return 8 * (i >> 2) + 4 * n + (i & 3); }

struct Unit { int pm, pn, ka; };
struct Gemm { const bf16_t* A; const bf16_t* Bt; int M, N, K, lda, ldb; };

struct StaticOrder {
    int nM, nN, nwg, G, c;
    __host__ __device__ void init(int M, int N, int G_, int c_) { nM = M / BM; nN = N / BM; nwg = nM * nN; G = G_; c = c_; }
    __host__ __device__ bool next(int i, Unit& u) const {
        const long L = (long)i * G + c; if (L >= nwg) return false;
        int wgid = (int)L; { const int q = nwg / NXCD, r = nwg % NXCD, xcd = wgid % NXCD, off = wgid / NXCD; wgid = (xcd < r ? xcd * (q + 1) : r * (q + 1) + (xcd - r) * q) + off; }
        const int nig = WGM * nN, gid = wgid / nig, fm = gid * WGM, gsz = (nM - fm) < WGM ? (nM - fm) : WGM;
        u.pm = fm + ((wgid % nig) % gsz); u.pn = (wgid % nig) / gsz; u.ka = 0; return true;
    }
    __device__ __forceinline__ void a_ready(const Unit&) const {}
    __device__ __forceinline__ void done(const Unit&) const {}
};

__device__ __forceinline__ unsigned cvt_pk_bf16(float lo, float hi) { unsigned r; asm volatile("v_cvt_pk_bf16_f32 %0, %1, %2" : "=v"(r) : "v"(lo), "v"(hi)); return r; }
typedef float f32x2 __attribute__((ext_vector_type(2)));
__device__ __forceinline__ f32x2 gelu_pk(f32x2 v) {
    const f32x2 av = __builtin_elementwise_abs(v), d = av * 0.2316418882f + 1.0f;
    f32x2 t; t.x = __builtin_amdgcn_rcpf(d.x); t.y = __builtin_amdgcn_rcpf(d.y);
    f32x2 q = t * 0.5307027145f + (-0.7265760135f); q = q * t + 0.7107068705f; q = q * t + (-0.142248368f); q = q * t + 0.127414796f; q = q * t;
    const f32x2 s = (v * v) * (-0.72134752044f);
    f32x2 e; e.x = __builtin_amdgcn_exp2f(s.x); e.y = __builtin_amdgcn_exp2f(s.y);
    const f32x2 m = v * (q * e), r = v - m;
    f32x2 o; o.x = v.x < 0.f ? m.x : r.x; o.y = v.y < 0.f ? m.y : r.y; return o;
}

template <int ACT  > struct EpiBf16 {
    static constexpr bool PERM = true, AFTER_DRAIN = false; static_assert(ACT == 0 || ACT == 1, "EpiBf16: ACT is 0 (none) or 1 (gelu_pk)");
    bf16_t* O; int ldc; const float* bias; int split_cols; size_t split_stride; float scale0;
    __device__ __forceinline__ void operator()(const f32x4 (&acc)[2][2][4][2], const Unit& u, int wr, int wc, int fr, int fq) const {
        const int row0 = u.pm * BM + wr * 64 + fr; int colt = u.pn * BM; bf16_t* base = O;
        float sc = 1.f; if (split_cols) { const int t = colt / split_cols; base += (size_t)t * split_stride; colt -= t * split_cols; if (t == 0) sc = scale0; }
        const int col0 = colt + wc * 32 + 8 * fq, bcol0 = u.pn * BM + wc * 32 + 8 * fq;
        f32x4 bv[2][2];
#pragma unroll
        for (int bj = 0; bj < 2; ++bj)
#pragma unroll
            for (int n = 0; n < 2; ++n) bv[bj][n] = bias ? *(const f32x4*)(bias + bcol0 + bj * HALF + 4 * n) : (f32x4){0.f, 0.f, 0.f, 0.f};
#pragma unroll
        for (int ai = 0; ai < 2; ++ai)
#pragma unroll
            for (int m = 0; m < 4; ++m) { bf16_t* rowp = base + (size_t)(row0 + ai * HALF + m * 16) * ldc + col0;
#pragma unroll
                for (int bj = 0; bj < 2; ++bj) { f32x4 v0 = acc[ai][bj][m][0] + bv[bj][0], v1 = acc[ai][bj][m][1] + bv[bj][1];
                    if (ACT == 1) { f32x2 a = gelu_pk((f32x2){v0[0], v0[1]}), b = gelu_pk((f32x2){v0[2], v0[3]}), c = gelu_pk((f32x2){v1[0], v1[1]}), d = gelu_pk((f32x2){v1[2], v1[3]});
                        v0 = (f32x4){a.x, a.y, b.x, b.y}; v1 = (f32x4){c.x, c.y, d.x, d.y}; }
                    v0 = v0 * sc; v1 = v1 * sc; u32x4 w; w.x = cvt_pk_bf16(v0[0], v0[1]); w.y = cvt_pk_bf16(v0[2], v0[3]); w.z = cvt_pk_bf16(v1[0], v1[1]); w.w = cvt_pk_bf16(v1[2], v1[3]);
                    *(u32x4*)(rowp + bj * HALF) = w; } }
    }
};

template <class Epi, class Sched, bool ALIGN_EPI = false, bool SP2 = false>
__device__ __forceinline__ void gemm_phase(PG8_LAS unsigned char* lds, const Gemm g, const Sched& S, const Epi& E) {
    int tid_ = threadIdx.x; asm volatile("" : "+v"(tid_));
    const int tid = tid_, wid = __builtin_amdgcn_readfirstlane(tid >> 6), lane = tid & 63, wr = wid >> 2, wc = wid & 3, fr = lane & 15, fq = lane >> 4;
    const int K = g.K, nt = K / BK;
    unsigned voffA[2], voffB[2];
#pragma unroll
    for (int i = 0; i < 2; ++i) { int R, C; stage_rc(tid * 16 + i * 8192, R, C); const int Rb = Epi::PERM ? ((R & ~31) + perm32(R & 31)) : R;
        voffA[i] = (unsigned)(R * g.lda + C) * 2u; voffB[i] = (unsigned)(Rb * g.ldb + C) * 2u; }
    const size_t kstep = (size_t)(BK * 2);
    const size_t hstepA = (size_t)HALF * g.lda * 2, hstepB = (size_t)HALF * g.ldb * 2;
    const size_t tstepA = 2 * hstepA, tstepB = 2 * hstepB;
    const unsigned ldsw = (unsigned)wid * 1024u;
    const int aoff = lds_byte(wr * 64 + fr, fq * 8), boff = lds_byte(wc * 32 + fr, fq * 8);
#define PG8_SA(b, h) (((b) * 2 + (h)) * HTB)
#define PG8_SB(b, h) ((4 + (b) * 2 + (h)) * HTB)
#define PG8_STAGE(bufoff, gbase, voff) do { _Pragma("unroll") for (int _i = 0; _i < 2; ++_i) \
        __builtin_amdgcn_global_load_lds((const unsigned*)((const char*)(gbase) + (voff)[_i]), (PG8_LAS unsigned*)(lds + (bufoff) + ldsw + _i * 8192), 16, 0, 0); } while (0)
#define PG8_LDA(dst, b, h) do { _Pragma("unroll") for (int m = 0; m < 4; ++m) _Pragma("unroll") for (int k = 0; k < 2; ++k) dst[m][k] = *(const PG8_LAS bf16x8*)(lds + PG8_SA(b, h) + aoff + m * 2048 + k * 1024); } while (0)
#define PG8_LDB(dst, b, h) do { _Pragma("unroll") for (int n = 0; n < 2; ++n) _Pragma("unroll") for (int k = 0; k < 2; ++k) dst[n][k] = *(const PG8_LAS bf16x8*)(lds + PG8_SB(b, h) + boff + n * 2048 + k * 1024); } while (0)
#define PG8_MMA(ai, bj, At, Bt) do { __builtin_amdgcn_s_setprio(1); _Pragma("unroll") for (int m = 0; m < 4; ++m) _Pragma("unroll") for (int n = 0; n < 2; ++n) _Pragma("unroll") for (int k = 0; k < 2; ++k) \
        acc[ai][bj][m][n] = __builtin_amdgcn_mfma_f32_16x16x32_bf16(Bt[n][k], At[m][k], acc[ai][bj][m][n], 0, 0, 0); __builtin_amdgcn_s_setprio(0); } while (0)
#define PG8_WAIT_V(n) asm volatile("s_waitcnt vmcnt(" #n ")" ::: "memory")
#define PG8_WAIT_L(n) asm volatile("s_waitcnt lgkmcnt(" #n ")" ::: "memory")
#define PG8_BAR __builtin_amdgcn_s_barrier()
#define PG8_SCHED __builtin_amdgcn_sched_barrier(0)
    Unit cur, nxt; int ui = 0;
    if (!S.next(0, cur)) return;
    f32x4 acc[2][2][4][2];
#pragma unroll
    for (int a = 0; a < 2; ++a)
#pragma unroll
        for (int b = 0; b < 2; ++b)
#pragma unroll
            for (int m = 0; m < 4; ++m)
#pragma unroll
                for (int n = 0; n < 2; ++n) acc[a][b][m][n] = (f32x4){0.f, 0.f, 0.f, 0.f};
    bf16x8 At[4][2], B0[2][2], B1[2][2];
    const char* cA = (const char*)g.A + (size_t)cur.pm * tstepA + (size_t)cur.ka * 2; const char* cB = (const char*)g.Bt + (size_t)cur.pn * tstepB;
    S.a_ready(cur);
    if constexpr (SP2) {
        PG8_STAGE(PG8_SB(0, 0), cB, voffB); PG8_STAGE(PG8_SB(0, 1), cB + hstepB, voffB); PG8_STAGE(PG8_SA(0, 0), cA, voffA); PG8_STAGE(PG8_SA(0, 1), cA + hstepA, voffA);
        if (wr == 1) PG8_BAR;
        PG8_WAIT_V(2); PG8_BAR;
        PG8_STAGE(PG8_SB(1, 0), cB + kstep, voffB); PG8_STAGE(PG8_SA(1, 0), cA + kstep, voffA); PG8_STAGE(PG8_SB(1, 1), cB + hstepB + kstep, voffB);
        PG8_WAIT_V(6); PG8_BAR;
    } else {
        PG8_STAGE(PG8_SB(0, 0), cB, voffB); PG8_STAGE(PG8_SA(0, 0), cA, voffA); PG8_STAGE(PG8_SB(0, 1), cB + hstepB, voffB); PG8_STAGE(PG8_SA(0, 1), cA + hstepA, voffA);
        if (wr == 1) PG8_BAR;
        PG8_WAIT_V(4); PG8_BAR;
        PG8_STAGE(PG8_SB(1, 0), cB + kstep, voffB); PG8_STAGE(PG8_SA(1, 0), cA + kstep, voffA); PG8_STAGE(PG8_SB(1, 1), cB + hstepB + kstep, voffB);
        PG8_WAIT_V(6); PG8_BAR;
    }
    for (;;) {
        const bool has_next = S.next(ui + 1, nxt);
        const char* nA = has_next ? (const char*)g.A + (size_t)nxt.pm * tstepA + (size_t)nxt.ka * 2 : cA; const char* nB = has_next ? (const char*)g.Bt + (size_t)nxt.pn * tstepB : cB;
#pragma unroll 1
        for (int t = 0; t < nt; t += 2) {
            const bool last = (t == nt - 2);
            const char* a1 = cA + (size_t)(t + 1) * kstep;
            const char* a2 = last ? nA : cA + (size_t)(t + 2) * kstep; const char* b2 = last ? nB : cB + (size_t)(t + 2) * kstep;
            const char* a3 = a2 + kstep; const char* b3 = b2 + kstep;
            if (last && has_next) S.a_ready(nxt);
            if constexpr (SP2) {
            PG8_LDB(B0, 0, 0); PG8_LDB(B1, 0, 1); PG8_SCHED; PG8_LDA(At, 0, 0); PG8_STAGE(PG8_SA(1, 1), a1 + hstepA, voffA);
            PG8_WAIT_V(8); PG8_WAIT_L(0); PG8_BAR; PG8_MMA(0, 0, At, B0); PG8_MMA(0, 1, At, B1); PG8_BAR; PG8_SCHED;
            PG8_LDA(At, 0, 1); PG8_STAGE(PG8_SB(0, 0), b2, voffB); PG8_STAGE(PG8_SB(0, 1), b2 + hstepB, voffB); PG8_STAGE(PG8_SA(0, 0), a2, voffA);
            PG8_WAIT_V(8); PG8_WAIT_L(0); PG8_BAR; PG8_MMA(1, 0, At, B0); PG8_MMA(1, 1, At, B1); PG8_BAR; PG8_SCHED;
            PG8_LDB(B0, 1, 0); PG8_LDB(B1, 1, 1); PG8_SCHED; PG8_LDA(At, 1, 0); PG8_STAGE(PG8_SA(0, 1), a2 + hstepA, voffA);
            PG8_WAIT_V(8); PG8_WAIT_L(0); PG8_BAR; PG8_MMA(0, 0, At, B0); PG8_MMA(0, 1, At, B1); PG8_BAR; PG8_SCHED;
            PG8_LDA(At, 1, 1); PG8_STAGE(PG8_SB(1, 0), b3, voffB); PG8_STAGE(PG8_SB(1, 1), b3 + hstepB, voffB); PG8_STAGE(PG8_SA(1, 0), a3, voffA);
            PG8_WAIT_V(8); PG8_WAIT_L(0); PG8_BAR; PG8_MMA(1, 0, At, B0); PG8_MMA(1, 1, At, B1); PG8_BAR; PG8_SCHED;
            } else {
            PG8_LDB(B0, 0, 0); PG8_SCHED; PG8_LDA(At, 0, 0); PG8_STAGE(PG8_SA(1, 1), a1 + hstepA, voffA);
            PG8_WAIT_L(8); PG8_BAR; PG8_WAIT_L(0); PG8_MMA(0, 0, At, B0); PG8_BAR; PG8_SCHED;
            PG8_LDB(B1, 0, 1); PG8_STAGE(PG8_SB(0, 0), b2, voffB);
            PG8_BAR; PG8_WAIT_L(0); PG8_MMA(0, 1, At, B1); PG8_BAR;
            PG8_LDA(At, 0, 1); PG8_STAGE(PG8_SA(0, 0), a2, voffA);
            PG8_BAR; PG8_WAIT_L(0); PG8_MMA(1, 0, At, B0); PG8_BAR; PG8_SCHED;
            PG8_STAGE(PG8_SB(0, 1), b2 + hstepB, voffB);
            PG8_WAIT_V(6); PG8_BAR; PG8_MMA(1, 1, At, B1); PG8_BAR;
            PG8_LDB(B0, 1, 0); PG8_SCHED; PG8_LDA(At, 1, 0); PG8_STAGE(PG8_SA(0, 1), a2 + hstepA, voffA);
            PG8_WAIT_L(8); PG8_BAR; PG8_WAIT_L(0); PG8_MMA(0, 0, At, B0); PG8_BAR; PG8_SCHED;
            PG8_LDB(B1, 1, 1); PG8_STAGE(PG8_SB(1, 0), b3, voffB);
            PG8_BAR; PG8_WAIT_L(0); PG8_MMA(0, 1, At, B1); PG8_BAR;
            PG8_LDA(At, 1, 1); PG8_STAGE(PG8_SA(1, 0), a3, voffA);
            PG8_BAR; PG8_WAIT_L(0); PG8_MMA(1, 0, At, B0); PG8_BAR; PG8_SCHED;
            PG8_STAGE(PG8_SB(1, 1), b3 + hstepB, voffB);
            PG8_WAIT_V(6); PG8_BAR; PG8_MMA(1, 1, At, B1); PG8_BAR;
            }
        }
        if constexpr (ALIGN_EPI) { if (wr == 0) PG8_BAR; }
        if constexpr (!Epi::AFTER_DRAIN) { E(acc, cur, wr, wc, fr, fq); S.done(cur); }
        if (!has_next) break;
#pragma unroll
        for (int a = 0; a < 2; ++a)
#pragma unroll
            for (int b = 0; b < 2; ++b)
#pragma unroll
                for (int m = 0; m < 4; ++m)
#pragma unroll
                    for (int n = 0; n < 2; ++n) acc[a][b][m][n] = (f32x4){0.f, 0.f, 0.f, 0.f};
        cur = nxt; cA = nA; cB = nB; ++ui;
        if constexpr (ALIGN_EPI) { if (wr == 1) PG8_BAR; }
    }
    PG8_WAIT_V(0);
    if constexpr (!ALIGN_EPI) { if (wr == 0) PG8_BAR; }
    PG8_BAR;
    if constexpr (Epi::AFTER_DRAIN) { E.fused(acc, cur, wr, wc, fr, fq, lds, wid, lane); S.done(cur); }
#undef PG8_SA
#undef PG8_SB
#undef PG8_STAGE
#undef PG8_LDA
#undef PG8_LDB
#undef PG8_MMA
#undef PG8_WAIT_V
#undef PG8_WAIT_L
#undef PG8_BAR
#undef PG8_SCHED
}
}

#include <hip/hip_bf16.h>
#include <cmath>
namespace attn_body {
using bf16=__hip_bfloat16;
using bf16x8=__attribute__((ext_vector_type(8)))short;
using s16x4=__attribute__((ext_vector_type(4)))short;
using f32x16=__attribute__((ext_vector_type(16)))float;
using u32x4=__attribute__((ext_vector_type(4)))unsigned;
constexpr int BATCH=8,NHEAD=4,SEQ=8192,D=64;
constexpr int QP=256,KP=128,VP=2048,OP=1024;
constexpr int NW=8,QBLK=32,QB=QBLK*NW,KVBLK=64,NQB=SEQ/QB;
constexpr int ATTN_UNIT_ROWS=QB;
__device__ __forceinline__ int crow(int r,int hi){return (r&3)+8*(r>>2)+4*hi;}
#define SBAR() __builtin_amdgcn_sched_barrier(0)
__device__ __forceinline__ void cmask(f32x16&p0,f32x16&p1,int jb,int qrel,int hi){
  const float NEG=-INFINITY; int kb=64*jb+4*hi;
  #pragma unroll
  for(int r=0;r<16;++r){int kv=kb+(r&3)+8*(r>>2); if(kv>qrel)p0[r]=NEG; if(kv+32>qrel)p1[r]=NEG;}
}

constexpr int NSLOT=3, SLOTB=8192;
constexpr int LDS_K=0, LDS_V=NSLOT*SLOTB, LDS_WS=2*NSLOT*SLOTB, LDS_OST=LDS_WS+NW*64*4, LDS_BYTES=LDS_OST+NW*4096;
constexpr float C2=0.125f*1.4426950408889634f;
__device__ __forceinline__ void glds16(const void*gsrc,unsigned lds_dst){unsigned keep;
  asm volatile("s_mov_b32 %0, m0\n\ts_mov_b32 m0, %2\n\ts_nop 0\n\tglobal_load_lds_dwordx4 %1, off\n\ts_mov_b32 m0, %0":"=&s"(keep):"v"(gsrc),"s"(lds_dst):"memory");}
__device__ __forceinline__ float max3f(float a,float b,float c){float r;asm("v_max3_f32 %0, %1, %2, %3":"=v"(r):"v"(a),"v"(b),"v"(c));return r;}
__device__ __forceinline__ float max2f(float a,float b){float r;asm("v_max_f32_e32 %0, %1, %2":"=v"(r):"v"(a),"v"(b));return r;}
__device__ __forceinline__ float fadd_s(float a,float b){float r;asm("v_add_f32_e32 %0, %1, %2":"=v"(r):"v"(a),"v"(b));return r;}
__device__ __forceinline__ float fsub_s(float a,float b){float r;asm("v_sub_f32_e32 %0, %1, %2":"=v"(r):"v"(a),"v"(b));return r;}
typedef float f32x2_t __attribute__((ext_vector_type(2))); typedef __bf16 bf16x2_t __attribute__((ext_vector_type(2)));
__device__ __forceinline__ unsigned cvtpk_s(float lo,float hi){f32x2_t v={lo,hi};bf16x2_t b=__builtin_convertvector(v,bf16x2_t);return __builtin_bit_cast(unsigned,b);}
#define WAIT_BAR(N) asm volatile("s_waitcnt vmcnt(" #N ") lgkmcnt(0)\n\ts_barrier":::"memory")

__device__ __forceinline__ void qkt(f32x16&p0,f32x16&p1,const char*Kslot,const bf16x8*qr,const f32x16&negm,int r32,int hi){
  const char*kb=Kslot+hi*1024+r32*16;
  #pragma unroll
  for(int d0=0;d0<4;++d0){
    const bf16x8 b0=*reinterpret_cast<const bf16x8*>(kb+d0*2048);
    const bf16x8 b1=*reinterpret_cast<const bf16x8*>(kb+d0*2048+512);
    if(d0==0){p0=__builtin_amdgcn_mfma_f32_32x32x16_bf16(b0,qr[0],negm,0,0,0);p1=__builtin_amdgcn_mfma_f32_32x32x16_bf16(b1,qr[0],negm,0,0,0);}
    else{p0=__builtin_amdgcn_mfma_f32_32x32x16_bf16(b0,qr[d0],p0,0,0,0);p1=__builtin_amdgcn_mfma_f32_32x32x16_bf16(b1,qr[d0],p1,0,0,0);}}
}
typedef __attribute__((address_space(3))) const char* lds_cptr;
typedef short v4i16_t __attribute__((ext_vector_type(4)));
__device__ __forceinline__ void kload8(bf16x8*kf,lds_cptr kp){
  kf[0]=*(const __attribute__((address_space(3))) bf16x8*)(kp);      kf[1]=*(const __attribute__((address_space(3))) bf16x8*)(kp+512);
  kf[2]=*(const __attribute__((address_space(3))) bf16x8*)(kp+2048); kf[3]=*(const __attribute__((address_space(3))) bf16x8*)(kp+2560);
  kf[4]=*(const __attribute__((address_space(3))) bf16x8*)(kp+4096); kf[5]=*(const __attribute__((address_space(3))) bf16x8*)(kp+4608);
  kf[6]=*(const __attribute__((address_space(3))) bf16x8*)(kp+6144); kf[7]=*(const __attribute__((address_space(3))) bf16x8*)(kp+6656);
}
__device__ __forceinline__ void kload2(bf16x8*kf,lds_cptr kp,int j){ kf[2*j]=*(const __attribute__((address_space(3))) bf16x8*)(kp+j*2048); kf[2*j+1]=*(const __attribute__((address_space(3))) bf16x8*)(kp+j*2048+512); }
__device__ __forceinline__ s16x4 vtr(lds_cptr p){ return __builtin_bit_cast(s16x4,__builtin_amdgcn_ds_read_tr16_b64_v4i16((__attribute__((address_space(3))) v4i16_t*)p)); }
__device__ __forceinline__ float rowmax(const f32x16&p0,const f32x16&p1){
  float a=max3f(p0[0],p0[1],p1[0]),b=max3f(p0[2],p0[3],p1[1]);a=max3f(a,p1[2],p1[3]);
  #pragma unroll
  for(int r=4;r<16;r+=4){a=max3f(a,p0[r],p0[r+1]);b=max3f(b,p0[r+2],p0[r+3]);a=max3f(a,p1[r],p1[r+1]);b=max3f(b,p1[r+2],p1[r+3]);}
  const float m=max2f(a,b);
  auto rr=__builtin_amdgcn_permlane32_swap(__float_as_uint(m),__float_as_uint(m),false,false);
  return max2f(__uint_as_float(rr[0]),__uint_as_float(rr[1]));
}
__device__ __forceinline__ void pv(f32x16*o,int vb,bf16x8 pa0,bf16x8 pa1,bf16x8 pa2,bf16x8 pa3){
  #pragma unroll
  for(int d0=0;d0<2;++d0){s16x4 lo[4],hi[4];
    #pragma unroll
    for(int ks=0;ks<4;++ks){
      asm volatile("ds_read_b64_tr_b16 %0,%1 offset:%c2":"=&v"(lo[ks]):"v"(vb),"i"(d0*4096+ks*1024):"memory");
      asm volatile("ds_read_b64_tr_b16 %0,%1 offset:%c2":"=&v"(hi[ks]):"v"(vb),"i"(d0*4096+ks*1024+512):"memory");}
    asm volatile("s_waitcnt lgkmcnt(0)":::"memory");SBAR();
    #define PK(k) (bf16x8){lo[k][0],lo[k][1],lo[k][2],lo[k][3],hi[k][0],hi[k][1],hi[k][2],hi[k][3]}
    o[d0]=__builtin_amdgcn_mfma_f32_32x32x16_bf16(pa0,PK(0),o[d0],0,0,0);
    o[d0]=__builtin_amdgcn_mfma_f32_32x32x16_bf16(pa1,PK(1),o[d0],0,0,0);
    o[d0]=__builtin_amdgcn_mfma_f32_32x32x16_bf16(pa2,PK(2),o[d0],0,0,0);
    o[d0]=__builtin_amdgcn_mfma_f32_32x32x16_bf16(pa3,PK(3),o[d0],0,0,0);
    #undef PK
  }
}

#ifndef ATTN_STORE16
#define ATTN_STORE16(p,v) (*(u32x4*)(p)=(v))
#endif
template<int THRL> __device__ __forceinline__ void attn_unit(int b,int h,int qb,const bf16*Q,const bf16*__restrict__ K,const bf16*__restrict__ V,bf16*O,char*shm){
  int tid_=threadIdx.x; asm volatile("":"+v"(tid_)); const int tid=tid_,lane=tid&63,r32=lane&31,hi=lane>>5; const int wid=__builtin_amdgcn_readfirstlane(tid>>6);
  const long rowbase=(long)b*SEQ; const int q0=qb*QB;
  const bf16*Qw=Q+(rowbase+q0+wid*QBLK)*QP+h*D;
  const bf16*Kh=K+rowbase*KP+(h>>1)*D,*Vh=V+rowbase*VP+(h>>1)*D;
  const unsigned lds0=(unsigned)(uintptr_t)shm;
  float*wsf=(float*)(shm+LDS_WS)+wid*64;
  const bf16*ksrc=Kh+(long)lane*KP+wid*8;
  const bf16*vsrc=Vh+(long)(16*(wid&3)+(lane>>2))*VP+(wid>>2)*32+(lane&3)*8;
  const unsigned kdst=lds0+LDS_K+wid*1024, vdst=lds0+LDS_V+wid*1024;
  #define DMA_K(t,slot) glds16(ksrc+(long)(t)*KVBLK*KP,(unsigned)__builtin_amdgcn_readfirstlane(kdst+(slot)))
  #define DMA_V(t,slot) glds16(vsrc+(long)(t)*KVBLK*VP,(unsigned)__builtin_amdgcn_readfirstlane(vdst+(slot)))
  const int vb0=(int)(lds0+LDS_V)+((lane>>4)&1)*32+(lane&3)*8+(4*hi+((lane&15)>>2))*64;
  const char*Kbase=shm+LDS_K; bf16x8 kf[8];
  const lds_cptr shm3=(lds_cptr)shm; const lds_cptr kp0=shm3+LDS_K+hi*1024+r32*16; const lds_cptr vp0=shm3+LDS_V+((lane>>4)&1)*32+(lane&3)*8+(4*hi+((lane&15)>>2))*64;
  const int NT=SEQ/KVBLK;
  DMA_K(0,0);DMA_V(0,0);DMA_K(1,SLOTB);
  bf16x8 qr[4];
  #pragma unroll
  for(int d0=0;d0<4;++d0)qr[d0]=*reinterpret_cast<const bf16x8*>(&Qw[(long)r32*QP+d0*16+hi*8]);
  float mhat=0.f,l_reg=0.f;f32x16 o[2];o[0]=f32x16{};o[1]=f32x16{};f32x16 negm=f32x16{};asm volatile("":"+v"(negm));
  #define CMASK(P0,P1,t) do{}while(0)
  bool resc=false;
  #define START(P0,P1) do{ const float rm=rowmax(P0,P1); resc=false; \
    { const float dl=rm; mhat=fadd_s(mhat,dl); \
      _Pragma("unroll") for(int r=0;r<16;++r){P0[r]=fsub_s(P0[r],dl);P1[r]=fsub_s(P1[r],dl);} \
      _Pragma("unroll") for(int r=0;r<16;++r)negm[r]=-mhat; asm volatile("":"+v"(negm)); } \
    _Pragma("unroll") for(int r=0;r<16;++r)P0[r]=__builtin_amdgcn_exp2f(P0[r]); }while(0)
  #define RESC() do{ if(resc){ asm volatile("s_waitcnt lgkmcnt(0)":::"memory"); \
      _Pragma("unroll") for(int d_=0;d_<2;++d_) _Pragma("unroll") for(int r=0;r<16;++r)o[d_][r]*=wsf[crow(r,hi)]; } }while(0)
  f32x16 pA0,pA1,pB0,pB1;
  int sl_prev=0,sl_cur=0,sl_next=SLOTB;
  #define ROT() do{sl_prev=sl_cur;sl_cur=sl_next;sl_next=(sl_next==(NSLOT-1)*SLOTB)?0:sl_next+SLOTB;}while(0)
  DMA_K(2,2*SLOTB);
  WAIT_BAR(3);
  qkt(pA0,pA1,Kbase,qr,negm,r32,hi);asm volatile("s_nop 15\n\ts_nop 7":"+v"(pA0),"+v"(pA1));CMASK(pA0,pA1,0);
  START(pA0,pA1);
  _Pragma("unroll") for(int r=0;r<16;++r)pA1[r]=__builtin_amdgcn_exp2f(pA1[r]);
  WAIT_BAR(0);
  DMA_K(3,0);DMA_V(1,SLOTB);
  ROT();
  kload8(kf,kp0+sl_cur);
  WAIT_BAR(2);
  s16x4 vlo[8],vhi[8]; u32x4 pw0,pw1,pw2,pw3;
  #define PKW(P,B) cvtpk_s(P[B],P[B+1])
  #define PAF(k) __builtin_bit_cast(bf16x8,pw##k)
  #define VFR(i) (bf16x8){vlo[i][0],vlo[i][1],vlo[i][2],vlo[i][3],vhi[i][0],vhi[i][1],vhi[i][2],vhi[i][3]}
  #define PIN(x) asm volatile("":"+v"(x))
  #define MX3(a,b,c) __builtin_fmaxf(__builtin_fmaxf((a),(b)),(c))
  #define GAPA(MF,A0,A1,A2,A3,W0,W1,PW) do{ MF; sacc+=A0; sacc+=A1; sacc+=A2; sacc+=A3; PIN(sacc); W0; W1; PIN(PW); SBAR(); }while(0)
  #define EX(v) __builtin_amdgcn_exp2f(v)
  #define GAPB(MF,X,B) do{ MF; X[B]=EX(X[B]); X[B+1]=EX(X[B+1]); X[B+2]=EX(X[B+2]); X[B+3]=EX(X[B+3]); PIN(X); SBAR(); }while(0)
  #define VRD(i) do{ vlo[i]=vtr(vp_+(((i)>>2)*4096+((i)&3)*1024)); vhi[i]=vtr(vp_+(((i)>>2)*4096+((i)&3)*1024+512)); }while(0)
  #define KRD(G,j) do{ if(G){ kload2(kf,kp0+sl_next,j); SBAR(); } }while(0)
  #define STEP(C0,C1,P0,P1,t,GK,GV,GL) do{ SBAR(); \
    const lds_cptr vp_=vp0+sl_prev; \
    VRD(0); SBAR(); float sacc=(P0[0]+P0[1]); \
    GAPA(C0=__builtin_amdgcn_mfma_f32_32x32x16_bf16(kf[0],qr[0],negm,0,0,0), P0[2],P0[3],P0[4],P0[5],     pw0[0]=PKW(P0,0), pw0[1]=PKW(P0,2), pw0); \
    VRD(4); SBAR(); GAPA(C1=__builtin_amdgcn_mfma_f32_32x32x16_bf16(kf[1],qr[0],negm,0,0,0), P0[6],P0[7],P0[8],P0[9],     pw0[2]=PKW(P0,4), pw0[3]=PKW(P0,6), pw0); \
    VRD(1); SBAR(); GAPA(C0=__builtin_amdgcn_mfma_f32_32x32x16_bf16(kf[2],qr[1],C0,0,0,0),   P0[10],P0[11],P0[12],P0[13], pw1[0]=PKW(P0,8), pw1[1]=PKW(P0,10), pw1); \
    VRD(5); SBAR(); GAPA(C1=__builtin_amdgcn_mfma_f32_32x32x16_bf16(kf[3],qr[1],C1,0,0,0),   P0[14],P0[15],P1[0],P1[1],   pw1[2]=PKW(P0,12),pw1[3]=PKW(P0,14), pw1); \
    VRD(2); SBAR(); GAPA(C0=__builtin_amdgcn_mfma_f32_32x32x16_bf16(kf[4],qr[2],C0,0,0,0),   P1[2],P1[3],P1[4],P1[5],     pw2[0]=PKW(P1,0), pw2[1]=PKW(P1,2), pw2); \
    VRD(6); SBAR(); GAPA(C1=__builtin_amdgcn_mfma_f32_32x32x16_bf16(kf[5],qr[2],C1,0,0,0),   P1[6],P1[7],P1[8],P1[9],     pw2[2]=PKW(P1,4), pw2[3]=PKW(P1,6), pw2); \
    VRD(3); SBAR(); GAPA(C0=__builtin_amdgcn_mfma_f32_32x32x16_bf16(kf[6],qr[3],C0,0,0,0),   P1[10],P1[11],P1[12],P1[13], pw3[0]=PKW(P1,8), pw3[1]=PKW(P1,10), pw3); \
    VRD(7); SBAR(); GAPA(C1=__builtin_amdgcn_mfma_f32_32x32x16_bf16(kf[7],qr[3],C1,0,0,0),   P1[14],P1[15],0.f,0.f,       pw3[2]=PKW(P1,12),pw3[3]=PKW(P1,14), pw3); \
    l_reg+=sacc; \
    if(GK){DMA_K((t)+3,sl_cur);} if(GV){DMA_V((t)+1,sl_next);} \
    CMASK(C0,C1,t); \
    { float a=MX3(C0[0],C0[1],C1[0]),b=MX3(C0[2],C0[3],C1[1]); a=MX3(a,C1[2],C1[3]); \
      _Pragma("unroll") for(int r=4;r<16;r+=4){a=MX3(a,C0[r],C0[r+1]);b=MX3(b,C0[r+2],C0[r+3]);a=MX3(a,C1[r],C1[r+1]);b=MX3(b,C1[r+2],C1[r+3]);} \
      float rm=__builtin_fmaxf(a,b); { auto rr=__builtin_amdgcn_permlane32_swap(__float_as_uint(rm),__float_as_uint(rm),false,false); rm=__builtin_fmaxf(__uint_as_float(rr[0]),__uint_as_float(rr[1])); } \
      resc=false; \
      if(__builtin_expect(__any(rm>(float)THRL),0)){ const float dl=__builtin_fmaxf(rm,0.f); mhat+=dl; \
        _Pragma("unroll") for(int r=0;r<16;++r){C0[r]-=dl;C1[r]-=dl;} \
        _Pragma("unroll") for(int r=0;r<16;++r)negm[r]=-mhat; asm volatile("":"+v"(negm)); \
        const float f=__builtin_amdgcn_exp2f(-dl); l_reg*=f; if(hi==0)wsf[r32]=f; resc=true; } } \
    SBAR(); \
    GAPB(o[0]=__builtin_amdgcn_mfma_f32_32x32x16_bf16(PAF(0),VFR(0),o[0],0,0,0), C0,0); \
    GAPB(o[1]=__builtin_amdgcn_mfma_f32_32x32x16_bf16(PAF(0),VFR(4),o[1],0,0,0), C0,4); \
    KRD(GL,0); GAPB(o[0]=__builtin_amdgcn_mfma_f32_32x32x16_bf16(PAF(1),VFR(1),o[0],0,0,0), C0,8); \
    KRD(GL,1); GAPB(o[1]=__builtin_amdgcn_mfma_f32_32x32x16_bf16(PAF(1),VFR(5),o[1],0,0,0), C0,12); \
    KRD(GL,2); GAPB(o[0]=__builtin_amdgcn_mfma_f32_32x32x16_bf16(PAF(2),VFR(2),o[0],0,0,0), C1,0); \
    KRD(GL,3); GAPB(o[1]=__builtin_amdgcn_mfma_f32_32x32x16_bf16(PAF(2),VFR(6),o[1],0,0,0), C1,4); \
    GAPB(o[0]=__builtin_amdgcn_mfma_f32_32x32x16_bf16(PAF(3),VFR(3),o[0],0,0,0), C1,8); \
    GAPB(o[1]=__builtin_amdgcn_mfma_f32_32x32x16_bf16(PAF(3),VFR(7),o[1],0,0,0), C1,12); \
    }while(0)
  int t=1;
  #undef CMASK
  #define CMASK(P0,P1,t) do{}while(0)
  for(;t+5<NT;t+=2){
    STEP(pB0,pB1,pA0,pA1,t,true,true,true);     WAIT_BAR(2); RESC(); ROT();
    STEP(pA0,pA1,pB0,pB1,t+1,true,true,true);   WAIT_BAR(2); RESC(); ROT();
  }
  #undef CMASK
  #define CMASK(P0,P1,t) do{}while(0)
  #define ENDW(tt) do{ if((tt)+3<NT){WAIT_BAR(2);} else if((tt)+2<NT){WAIT_BAR(1);} else {WAIT_BAR(0);} }while(0)
  for(;t+1<NT;t+=2){
    STEP(pB0,pB1,pA0,pA1,t,(t+3<NT),(t+1<NT),(t+1<NT));       ENDW(t);   RESC(); ROT();
    STEP(pA0,pA1,pB0,pB1,t+1,(t+4<NT),(t+2<NT),(t+2<NT));     ENDW(t+1); RESC(); ROT();
  }
  STEP(pB0,pB1,pA0,pA1,NT-1,false,false,false); RESC();
  { float sacc=pB0[0]+pB0[1]; _Pragma("unroll") for(int r=2;r<16;++r)sacc+=pB0[r]; _Pragma("unroll") for(int r=0;r<16;++r)sacc+=pB1[r]; l_reg+=sacc;
    pw0=(u32x4){PKW(pB0,0),PKW(pB0,2),PKW(pB0,4),PKW(pB0,6)};pw1=(u32x4){PKW(pB0,8),PKW(pB0,10),PKW(pB0,12),PKW(pB0,14)};pw2=(u32x4){PKW(pB1,0),PKW(pB1,2),PKW(pB1,4),PKW(pB1,6)};pw3=(u32x4){PKW(pB1,8),PKW(pB1,10),PKW(pB1,12),PKW(pB1,14)};
    SBAR(); pv(o,vb0+sl_cur,PAF(0),PAF(1),PAF(2),PAF(3)); }
  #undef PKW
  #undef PAF
  #undef VFR
  #undef PIN
  #undef MX3
  #undef GAPA
  #undef GAPB
  #undef EX
  #undef VRD
  #undef KRD
  #undef STEP
  #undef ENDW
  {auto rr=__builtin_amdgcn_permlane32_swap(__float_as_uint(l_reg),__float_as_uint(l_reg),false,false);l_reg=__uint_as_float(rr[0])+__uint_as_float(rr[1]);}
  if(hi==0)wsf[32+r32]=l_reg;asm volatile("s_waitcnt lgkmcnt(0)":::"memory");
  float rli[16];
  #pragma unroll
  for(int r=0;r<16;++r)rli[r]=__builtin_amdgcn_rcpf(wsf[32+crow(r,hi)]);
  bf16*Ow=O+(rowbase+q0+wid*QBLK)*OP+h*D;
  { bf16*stg=(bf16*)(shm+LDS_OST)+wid*2048;
    #pragma unroll
    for(int r=0;r<16;++r){const int orow=crow(r,hi);
      #pragma unroll
      for(int d0=0;d0<2;++d0)stg[orow*64+d0*32+r32]=__float2bfloat16(o[d0][r]*rli[r]);}
    asm volatile("s_waitcnt lgkmcnt(0)":::"memory");
    #pragma unroll
    for(int i=0;i<4;++i){const int row=i*8+(lane>>3),ch=lane&7; const u32x4 v=*(const u32x4*)(stg+row*64+ch*8); ATTN_STORE16(Ow+(long)row*OP+ch*8,v);} }
  asm volatile("s_waitcnt lgkmcnt(0)\n\ts_barrier":::"memory");
  #undef DMA_K
  #undef DMA_V
  #undef CMASK
  #undef START
  #undef RESC
  #undef ROT
}
constexpr int ATTN_LDS_BYTES=LDS_BYTES;
struct AttnTensors { const bf16* Q; const bf16* K; const bf16* V; bf16* O; };
struct AttnUnit { int b; int h; int qb; };
struct StaticOrder {
  int vcu;
  __device__ __forceinline__ explicit StaticOrder(int vcu_):vcu(vcu_){}
  __device__ __forceinline__ bool next(int i,AttnUnit&u)const{ if(i>=4)return false; const int x=vcu>>5,j=vcu&31,grp=2*x+(i>>1); u.b=grp>>1; u.h=(grp&1)*2+(i&1); u.qb=j; return true; }
  __device__ __forceinline__ void a_ready(const AttnUnit&)const{}
  __device__ __forceinline__ void done(const AttnUnit&)const{}
};
template<class Sched,int THRL=8> __device__ __forceinline__ void attn_phase(char*lds,const AttnTensors&T,const Sched&S){
  AttnUnit u;
  for(int i=0;S.next(i,u);++i){ S.a_ready(u); attn_unit<THRL>(u.b,u.h,u.qb,T.Q,T.K,T.V,T.O,lds); S.done(u); }
}
#undef SBAR
#undef WAIT_BAR
}

#define GAS __attribute__((address_space(1)))
#define LAS __attribute__((address_space(3)))
typedef unsigned short bf16;
typedef unsigned v4u __attribute__((ext_vector_type(4)));
typedef float f32x4 __attribute__((ext_vector_type(4)));
typedef short bf16x8 __attribute__((ext_vector_type(8)));
typedef GAS unsigned gu32;
typedef GAS unsigned long long gu64;
#define RLX_AGENT __ATOMIC_RELAXED, __HIP_MEMORY_SCOPE_AGENT
#define LDS_WAIT() asm volatile("s_waitcnt lgkmcnt(0)" ::: "memory")
#define VM_WAIT() asm volatile("s_waitcnt vmcnt(0)" ::: "memory")
__device__ __forceinline__ unsigned long long rt() { return __builtin_amdgcn_s_memrealtime(); }
__device__ __forceinline__ unsigned f2bf(float f) { unsigned u = __builtin_bit_cast(unsigned, f); return (u + 0x7fffu + ((u >> 16) & 1u)) >> 16; }
__device__ __forceinline__ unsigned pk2(float lo, float hi) { return f2bf(lo) | (f2bf(hi) << 16); }

#define XB_TMO      128
#define XB_XCNT(j)  (256  + 64 * (j))
#define XB_XSUB(j)  (1280 + 64 * (j))
#define XB_XGEN(j)  (2304 + 64 * (j))
#define XB_TOP      3328
#define XB_TOPGEN   3392
#define XCD_BAR_WORDS 3456
#define XB_SPIN_CAP (1u << 18)

__device__ __forceinline__ unsigned xb_ld(unsigned* p)              { return __hip_atomic_load(p, __ATOMIC_RELAXED, __HIP_MEMORY_SCOPE_AGENT); }
__device__ __forceinline__ unsigned xb_add(unsigned* p, unsigned v) { return __hip_atomic_fetch_add(p, v, __ATOMIC_RELAXED, __HIP_MEMORY_SCOPE_AGENT); }
__device__ __forceinline__ unsigned xb_xcc_id() { return (unsigned)__builtin_amdgcn_s_getreg((3 << 11) | 20) & 0xFu; }
#define XB_SPIN(cond, bar) do { unsigned _sp = 0; while (cond) { __builtin_amdgcn_s_sleep(1); \
    if ((++_sp & 255u) == 0u) { if (xb_ld(&(bar)[XB_TMO])) break; if (_sp > XB_SPIN_CAP) { atomicAdd(&(bar)[XB_TMO], 1u); break; } } } } while (0)

struct XcdBarrier {
    unsigned* bar; unsigned x;
    volatile LAS unsigned* st;
};

__device__ __forceinline__ XcdBarrier xcd_barrier_post(unsigned* bar, volatile LAS unsigned* st) {
    XcdBarrier b; b.bar = bar; b.x = xb_xcc_id(); b.st = st;
    if (threadIdx.x == 0) (void)xb_add(&bar[XB_XCNT(b.x)], 1u);
    return b;
}
__device__ __forceinline__ void xcd_barrier_complete(unsigned* bar, unsigned x, unsigned& nloc, unsigned& nx) {
    const unsigned G = gridDim.x * gridDim.y * gridDim.z;
    unsigned sum, cnt, mine, sp = 0u;
    for (;;) {
        sum = 0u; cnt = 0u; mine = 0u;
#pragma unroll
        for (unsigned j = 0; j < 16; ++j) { const unsigned c = xb_ld(&bar[XB_XCNT(j)]); sum += c; cnt += (c > 0u) ? 1u : 0u; mine = (j == x) ? c : mine; }
        if (sum == G) break;
        __builtin_amdgcn_s_sleep(1);
        if ((++sp & 255u) == 0u) { if (xb_ld(&bar[XB_TMO])) break; if (sp > XB_SPIN_CAP) { atomicAdd(&bar[XB_TMO], 1u); break; } }
    }
    nloc = mine > 0u ? mine : 1u; nx = cnt > 0u ? cnt : 1u;
}

__device__ __forceinline__ void xcd_barrier(const XcdBarrier& b) {
    asm volatile("s_waitcnt vmcnt(0)" ::: "memory");
    __syncthreads();
    if (threadIdx.x == 0) {
        unsigned* bar = b.bar;
        __builtin_amdgcn_s_waitcnt(0);
        unsigned nloc = b.st[0], nx = b.st[1];
        if (nloc == 0u) { xcd_barrier_complete(bar, b.x, nloc, nx); b.st[0] = nloc; b.st[1] = nx; }
        const unsigned old = xb_add(&bar[XB_XSUB(b.x)], 1u);
        const unsigned gen = old / nloc;
        if (old + 1u == (gen + 1u) * nloc) {
            __builtin_amdgcn_fence(__ATOMIC_RELEASE, "agent");
            asm volatile("s_waitcnt vmcnt(0)" ::: "memory");
            const unsigned og = xb_add(&bar[XB_TOP], 1u);
            const unsigned tg = og / nx;
            if (og + 1u == (tg + 1u) * nx) xb_add(&bar[XB_TOPGEN], 1u);
            else XB_SPIN(xb_ld(&bar[XB_TOPGEN]) == tg, bar);
            __builtin_amdgcn_fence(__ATOMIC_ACQUIRE, "agent");
            xb_add(&bar[XB_XGEN(b.x)], 1u);
            asm volatile("s_waitcnt vmcnt(0)" ::: "memory");
        } else {
            XB_SPIN(xb_ld(&bar[XB_XGEN(b.x)]) == gen, bar);
            __builtin_amdgcn_fence(__ATOMIC_ACQUIRE, "agent");
            asm volatile("s_waitcnt vmcnt(0)" ::: "memory");
        }
    }
    __syncthreads();
}


namespace pg8 {
__device__ __forceinline__ float bflo(unsigned w) { return __uint_as_float(w << 16); }
__device__ __forceinline__ float bfhi(unsigned w) { return __uint_as_float(w & 0xffff0000u); }
__device__ __forceinline__ float sigm(float z) { return __builtin_amdgcn_rcpf(1.0f + __builtin_amdgcn_exp2f(-1.4426950408889634f * z)); }
typedef unsigned u32x2 __attribute__((ext_vector_type(2)));

struct BranchOrder : StaticOrder {
    __device__ bool next(int i, Unit& u) const { if (!StaticOrder::next(i, u)) return false; u.ka = (u.pn >> 2) * 256; return true; }
};
struct EpiGate {
    static constexpr bool PERM = false, AFTER_DRAIN = false;
    const bf16_t* P; const float* bg; bf16_t* O;
    __device__ __forceinline__ void operator()(const f32x4 (&acc)[2][2][4][2], const Unit& u, int wr, int wc, int fr, int fq) const {
        const int d0 = u.pn * 64 + 16 * wc + 4 * fq;
        f32x4 bv[2][2];
#pragma unroll
        for (int bj = 0; bj < 2; ++bj)
#pragma unroll
            for (int n = 0; n < 2; ++n) bv[bj][n] = *(const f32x4*)(bg + (2 * bj + n) * 1024 + d0);
#pragma unroll
        for (int ai = 0; ai < 2; ++ai)
#pragma unroll
            for (int m = 0; m < 4; ++m) { const size_t row = (size_t)(u.pm * BM + ai * HALF + wr * 64 + m * 16 + fr); const bf16_t* prow = P + row * 4096 + d0;
                f32x4 s = (f32x4){0.f, 0.f, 0.f, 0.f};
#pragma unroll
                for (int bj = 0; bj < 2; ++bj)
#pragma unroll
                    for (int n = 0; n < 2; ++n) { const u32x2 pw = *(const u32x2*)(prow + (2 * bj + n) * 1024); const f32x4 z = acc[ai][bj][m][n] + bv[bj][n];
                        s[0] += sigm(z[0]) * bflo(pw.x); s[1] += sigm(z[1]) * bfhi(pw.x); s[2] += sigm(z[2]) * bflo(pw.y); s[3] += sigm(z[3]) * bfhi(pw.y); }
                u32x2 w; w.x = cvt_pk_bf16(s[0], s[1]); w.y = cvt_pk_bf16(s[2], s[3]); *(u32x2*)(O + row * 1024 + d0) = w; }
    }
};
struct EpiResid {
    static constexpr bool PERM = false, AFTER_DRAIN = false;
    float* H; float alpha;
    __device__ __forceinline__ void operator()(const f32x4 (&acc)[2][2][4][2], const Unit& u, int wr, int wc, int fr, int fq) const {
        const int row0 = u.pm * BM + wr * 64 + fr, col0 = u.pn * BM + wc * 32 + 4 * fq;
#pragma unroll
        for (int ai = 0; ai < 2; ++ai)
#pragma unroll
            for (int m = 0; m < 4; ++m) { float* rowp = H + (size_t)(row0 + ai * HALF + m * 16) * 1024 + col0;
#pragma unroll
                for (int bj = 0; bj < 2; ++bj)
#pragma unroll
                    for (int n = 0; n < 2; ++n) { f32x4* p = (f32x4*)(rowp + bj * HALF + n * 16); const f32x4 h = *p; *p = h * alpha + acc[ai][bj][m][n]; } }
    }
};
struct EpiSwiglu {
    static constexpr bool PERM = true, AFTER_DRAIN = false;
    bf16_t* O; const float* bgu;
    __device__ __forceinline__ void operator()(const f32x4 (&acc)[2][2][4][2], const Unit& u, int wr, int wc, int fr, int fq) const {
        const int e = u.pn >> 3, ct = u.pn & 7, cc0 = ct * 128 + wc * 32 + 8 * fq;
        const float* bb = bgu + e * 2048 + cc0;
        f32x4 bg[2], bl[2];
#pragma unroll
        for (int n = 0; n < 2; ++n) { bg[n] = *(const f32x4*)(bb + 4 * n); bl[n] = *(const f32x4*)(bb + 1024 + 4 * n); }
#pragma unroll
        for (int ai = 0; ai < 2; ++ai)
#pragma unroll
            for (int m = 0; m < 4; ++m) { const size_t row = (size_t)(u.pm * BM + ai * HALF + wr * 64 + m * 16 + fr);
                float o[8];
#pragma unroll
                for (int n = 0; n < 2; ++n)
#pragma unroll
                    for (int j = 0; j < 4; ++j) { float gl = acc[ai][0][m][n][j] + bg[n][j], li = acc[ai][1][m][n][j] + bl[n][j];
                        gl = fminf(gl, 7.0f); li = fminf(fmaxf(li, -7.0f), 7.0f); o[4 * n + j] = gl * sigm(1.702f * gl) * (li + 1.0f); }
                u32x4 w; w.x = cvt_pk_bf16(o[0], o[1]); w.y = cvt_pk_bf16(o[2], o[3]); w.z = cvt_pk_bf16(o[4], o[5]); w.w = cvt_pk_bf16(o[6], o[7]);
                *(u32x4*)(O + row * 1024 + cc0) = w; }
    }
};
struct EpiDown {
    static constexpr bool PERM = true, AFTER_DRAIN = false;
    bf16_t* O; const float* bd;
    __device__ __forceinline__ void operator()(const f32x4 (&acc)[2][2][4][2], const Unit& u, int wr, int wc, int fr, int fq) const {
        const int e = u.pn >> 2, ct = u.pn & 3, col0 = ct * 256 + wc * 32 + 8 * fq;
        const float* bb = bd + e * 1024 + col0;
        f32x4 bv[2][2];
#pragma unroll
        for (int bj = 0; bj < 2; ++bj)
#pragma unroll
            for (int n = 0; n < 2; ++n) bv[bj][n] = *(const f32x4*)(bb + bj * HALF + 4 * n);
#pragma unroll
        for (int ai = 0; ai < 2; ++ai)
#pragma unroll
            for (int m = 0; m < 4; ++m) { bf16_t* rowp = O + (size_t)(u.pm * BM + ai * HALF + wr * 64 + m * 16 + fr) * 1024 + col0;
#pragma unroll
                for (int bj = 0; bj < 2; ++bj) { const f32x4 v0 = acc[ai][bj][m][0] + bv[bj][0], v1 = acc[ai][bj][m][1] + bv[bj][1];
                    u32x4 w; w.x = cvt_pk_bf16(v0[0], v0[1]); w.y = cvt_pk_bf16(v0[2], v0[3]); w.z = cvt_pk_bf16(v1[0], v1[1]); w.w = cvt_pk_bf16(v1[2], v1[3]);
                    *(u32x4*)(rowp + bj * HALF) = w; } }
    }
};
struct MoeOrder {
    const PG8_LAS int* tab; int nct, G, c;
    __device__ bool next(int i, Unit& u) const {
        const int L = i * G + c; if (L >= tab[32]) return false;
        int e = 0;
#pragma unroll 1
        while (e < 31 && L >= tab[e + 1]) ++e;
        const int r = L - tab[e], nt = (tab[e + 1] - tab[e]) / nct, nig = 8 * nct, gid = r / nig, fm = gid * 8, gsz = (nt - fm) < 8 ? (nt - fm) : 8, rr = r % nig;
        u.pm = tab[33 + e] + fm + (rr % gsz); u.pn = e * nct + rr / gsz; u.ka = 0; return true;
    }
    __device__ __forceinline__ void a_ready(const Unit&) const {}
    __device__ __forceinline__ void done(const Unit&) const {}
};
}

constexpr int NWAVES = 8;
#ifndef MK_ONE_LAUNCH
#define MK_ONE_LAUNCH 0
#endif
constexpr int NB = 8, SEQ = 8192, D = 1024, M = NB * SEQ, DEPTH = 2;
constexpr int IN_COLS = 6144, ZSW = 2048;
constexpr int NE = 32, TOPK = 4, RMAX = M * TOPK + NE * 256;
constexpr float DN_ALPHA = 1.4142135623730951f, LN_EPS = 1e-5f, RMS_EPS = 1e-6f;
constexpr float QSCALE = 0.125f * 1.4426950408889634f;
constexpr int NSUB = 11, NPH = 1 + DEPTH * NSUB;
constexpr size_t MiB = 1u << 20;
constexpr size_t WS_CTL = 0, CTL_ZERO_BYTES = 1 * MiB;
constexpr size_t WS_TOPE = 1 * MiB, WS_TOPW = 2 * MiB, WS_TOPR = 3 * MiB, WS_WGB = 4 * MiB, WS_ROPE = 5 * MiB;
constexpr size_t WS_W0 = 8 * MiB, W_LAYER = 208 * MiB;
constexpr size_t WO_INS = 0, WO_G = 4 * MiB, WO_B = 12 * MiB, WO_O = 14 * MiB, WO_GU = 16 * MiB, WO_D = 144 * MiB;
constexpr size_t WS_HB = WS_W0 + 2 * W_LAYER;
constexpr size_t WS_OV = WS_HB + 128 * MiB;
constexpr size_t WS_ZS = WS_OV, WS_QN = WS_OV + 256 * MiB, WS_KN = WS_OV + 288 * MiB, WS_BR = WS_OV + 304 * MiB, WS_MG = WS_OV + 432 * MiB, WS_P = WS_OV + 560 * MiB;
constexpr size_t WS_XS = WS_OV, WS_Y = WS_OV, WS_HA = WS_OV + 528 * MiB;
constexpr size_t WS_END = WS_OV + 1072 * MiB;
static_assert((size_t)RMAX * 1024 * 2 <= 528 * MiB, "MoE row buffers");
constexpr int CW_TMO = 0, CW_CODE = 1, CW_BAR = 4096, CW_CNT = 8192;
constexpr int RING_OFF = 0, RING_BYTES = 131072;
constexpr int LDSCTL_OFF = RING_BYTES, MISC_OFF = LDSCTL_OFF + 320;
constexpr int TAB_OFF = LDSCTL_OFF + 1024;
constexpr int HIST_OFF = TAB_OFF + 512, LG_OFF = TAB_OFF + 1024;
constexpr int LDS_BYTES = 147456;

struct Args { const float* in[26]; float* out; unsigned char* ws; int ph_lo, ph_hi; };
struct Frame { LAS unsigned char* lds; volatile LAS unsigned* MISC; gu32* ctl; int tid, lane, wave, vcu, G, wg; };

using pg8::bflo; using pg8::bfhi; using pg8::sigm; using pg8::cvt_pk_bf16;
typedef unsigned v2u __attribute__((ext_vector_type(2)));
__device__ __forceinline__ float wave_sum(float v) {
#pragma unroll
    for (int o = 1; o < 64; o <<= 1) v += __shfl_xor(v, o);
    return v;
}
__device__ __forceinline__ void unpack8(const v4u v, float (&x)[8]) { x[0] = bflo(v.x); x[1] = bfhi(v.x); x[2] = bflo(v.y); x[3] = bfhi(v.y); x[4] = bflo(v.z); x[5] = bfhi(v.z); x[6] = bflo(v.w); x[7] = bfhi(v.w); }
__device__ __forceinline__ v4u pack8(const float (&x)[8]) { v4u o; o.x = cvt_pk_bf16(x[0], x[1]); o.y = cvt_pk_bf16(x[2], x[3]); o.z = cvt_pk_bf16(x[4], x[5]); o.w = cvt_pk_bf16(x[6], x[7]); return o; }

struct RmId { __device__ __forceinline__ int operator()(int n) const { return n; } };
struct RmGate { __device__ __forceinline__ int operator()(int n) const { const int g = n >> 10, d = n & 1023, pn = d >> 6, dl = d & 63; return 256 * pn + 128 * (g >> 1) + 32 * (dl >> 4) + 16 * (g & 1) + (dl & 15); } };
struct RmGlu { __device__ __forceinline__ int operator()(int n) const { const int j = n & 1023, lin = n >> 10; return 256 * (j >> 7) + 128 * lin + (j & 127); } };
template <class RM>
__device__ __forceinline__ void transpose_item(const float* W, int ldw, bf16* WT, int ldt, const RM rm, LAS float* scr, int kb, int nb, int lane) {
    const int k0 = 64 * kb, n0 = 32 * nb;
#pragma unroll 8
    for (int i = 0; i < 32; ++i) { const int kk = 2 * i + (lane >> 5); scr[kk * 33 + (lane & 31)] = W[(size_t)(k0 + kk) * ldw + n0 + (lane & 31)]; }
    LDS_WAIT(); asm volatile("" ::: "memory");
    const int c = lane & 7;
#pragma unroll
    for (int j = 0; j < 4; ++j) { const int n = (lane >> 3) + 8 * j; const LAS float* s = scr + (8 * c) * 33 + n;
        v4u o; o.x = cvt_pk_bf16(s[0 * 33], s[1 * 33]); o.y = cvt_pk_bf16(s[2 * 33], s[3 * 33]); o.z = cvt_pk_bf16(s[4 * 33], s[5 * 33]); o.w = cvt_pk_bf16(s[6 * 33], s[7 * 33]);
        *(GAS v4u*)(WT + (size_t)rm(n0 + n) * ldt + k0 + 8 * c) = o; }
    LDS_WAIT(); asm volatile("" ::: "memory");
}
__device__ __forceinline__ void ln16(f32x4 (&v)[4], const float* g, const float* b, int lane) {
    float s = 0.f;
#pragma unroll
    for (int j = 0; j < 4; ++j) s += (v[j].x + v[j].y) + (v[j].z + v[j].w);
    const float mean = wave_sum(s) * (1.f / D); float s2 = 0.f;
#pragma unroll
    for (int j = 0; j < 4; ++j) { v[j] = v[j] - mean; s2 += (v[j].x * v[j].x + v[j].y * v[j].y) + (v[j].z * v[j].z + v[j].w * v[j].w); }
    const float rstd = 1.f / sqrtf(wave_sum(s2) * (1.f / D) + LN_EPS);
#pragma unroll
    for (int j = 0; j < 4; ++j) { const f32x4 gv = *(const f32x4*)(g + 4 * lane + 256 * j), bv = *(const f32x4*)(b + 4 * lane + 256 * j); v[j] = v[j] * rstd * gv + bv; }
}
__device__ __forceinline__ void store_row(const f32x4 (&v)[4], float* hrow, bf16* brow, int lane) {
#pragma unroll
    for (int j = 0; j < 4; ++j) { *(f32x4*)(hrow + 4 * lane + 256 * j) = v[j]; v2u w; w.x = cvt_pk_bf16(v[j].x, v[j].y); w.y = cvt_pk_bf16(v[j].z, v[j].w); *(v2u*)(brow + 4 * lane + 256 * j) = w; }
}

__device__ __forceinline__ void phase_prologue(Frame& F, const Args& a) {
    LAS float* scr = (LAS float*)(F.lds + RING_OFF + F.wave * 16384);
    const int gw = F.wg * NWAVES + F.wave, NGW = F.G * NWAVES;
    constexpr int I_INS = 16 * 64, I_G = 16 * 128, I_B = 3 * 4 * 32, I_O = 16 * 32, I_GU = NE * 16 * 64, I_D = NE * 16 * 32, I_TOT = I_INS + I_G + I_B + I_O + I_GU + I_D;
    for (int it = gw; it < DEPTH * I_TOT; it += NGW) {
        const int l = it / I_TOT; int r = it - l * I_TOT; unsigned char* wl = a.ws + WS_W0 + (size_t)l * W_LAYER;
        if (r < I_INS) { transpose_item(a.in[3] + (size_t)l * D * IN_COLS, IN_COLS, (bf16*)(wl + WO_INS), D, RmId(), scr, r / 64, r % 64, F.lane); continue; } r -= I_INS;
        if (r < I_G) { transpose_item(a.in[3] + (size_t)l * D * IN_COLS + 2048, IN_COLS, (bf16*)(wl + WO_G), D, RmGate(), scr, r / 128, r % 128, F.lane); continue; } r -= I_G;
        if (r < I_B) { const int g = r / 128, rr = r % 128; transpose_item(a.in[14] + (size_t)(l * 4 + g) * 256 * D, D, (bf16*)(wl + WO_B) + (size_t)g * D * 256, 256, RmId(), scr, rr / 32, rr % 32, F.lane); continue; } r -= I_B;
        if (r < I_O) { transpose_item(a.in[15] + (size_t)l * D * D, D, (bf16*)(wl + WO_O), D, RmId(), scr, r / 32, r % 32, F.lane); continue; } r -= I_O;
        if (r < I_GU) { const int e = r / 1024, rr = r % 1024; transpose_item(a.in[20] + (size_t)(l * NE + e) * D * 2048, 2048, (bf16*)(wl + WO_GU) + (size_t)e * 2048 * D, D, RmGlu(), scr, rr / 64, rr % 64, F.lane); continue; } r -= I_GU;
        { const int e = r / 512, rr = r % 512; transpose_item(a.in[22] + (size_t)(l * NE + e) * D * D, D, (bf16*)(wl + WO_D) + (size_t)e * D * D, D, RmId(), scr, rr / 32, rr % 32, F.lane); }
    }
    const int gt = F.wg * (NWAVES * 64) + F.tid, NT_ = F.G * NWAVES * 64;
    for (int o = gt; o < DEPTH * 262144; o += NT_) {
        const int l = o >> 18, r = o & 262143, d = r >> 8, k = r & 255, grp = k >> 6, c = k & 63;
        const float* pw = a.in[12] + ((size_t)(l * 4 + grp) * 64 + c) * 64; const float* ps = a.in[13] + l * 256 + grp * 64; const float* wb = a.in[14] + ((size_t)(l * 4 + 3) * 256 + grp * 64) * D + d;
        float s = 0.f;
        for (int d2 = 0; d2 < 64; ++d2) s += pw[d2] * ps[d2] * wb[(size_t)d2 * D];
        ((bf16*)(a.ws + WS_W0 + (size_t)l * W_LAYER + WO_B))[(size_t)3 * D * 256 + (size_t)d * 256 + k] = (bf16)(cvt_pk_bf16(s, 0.f) & 0xffffu);
    }
    for (int i = gt; i < 192 * 16; i += NT_) { const int p = i >> 4, fi = i & 15, pp = p < 128 ? p : p - 128;
        double th = (fi & 3) == 0 ? 1.0 : (fi & 3) == 1 ? 0.5623413251903491 : (fi & 3) == 2 ? 0.31622776601683794 : 0.1778279410038923;
        for (int k = 0; k < (fi >> 2); ++k) th *= 0.1;
        const double t2 = th * th; double c = 1.0, s = th, tc = 1.0, tsn = th;
        for (int k = 1; k <= 12; ++k) { tc *= -t2 / (double)((2 * k - 1) * (2 * k)); tsn *= -t2 / (double)((2 * k) * (2 * k + 1)); c += tc; s += tsn; }
        double rc = 1.0, rs = 0.0, bc = c, bs = s;
        for (int n = pp; n > 0; n >>= 1) { if (n & 1) { const double t = rc * bc - rs * bs; rs = rc * bs + rs * bc; rc = t; } const double t = bc * bc - bs * bs; bs = 2.0 * bc * bs; bc = t; }
        float* rope = (float*)(a.ws + WS_ROPE); rope[p * 32 + fi] = (float)rc; rope[p * 32 + 16 + fi] = (float)rs; }
    for (int m = gw; m < M; m += NGW) { f32x4 v[4];
#pragma unroll
        for (int j = 0; j < 4; ++j) v[j] = *(const f32x4*)(a.in[0] + (size_t)m * D + 4 * F.lane + 256 * j);
        ln16(v, a.in[1], a.in[2], F.lane); store_row(v, a.out + (size_t)m * D, (bf16*)(a.ws + WS_HB) + (size_t)m * D, F.lane); }
}

__device__ __forceinline__ void phase_prep(Frame& F, const Args& a, int l) {
    const bf16* zs = (const bf16*)(a.ws + WS_ZS); bf16* qn = (bf16*)(a.ws + WS_QN); bf16* kn = (bf16*)(a.ws + WS_KN); bf16* br = (bf16*)(a.ws + WS_BR);
    {
        LAS float* sbuf = (LAS float*)(F.lds + RING_OFF);
        LAS float* ybuf = (LAS float*)(F.lds + RING_OFF + 65536);
        const float* cw = a.in[8] + l * 31 * 256; const float* lg = a.in[10] + l * 256; const float* lb = a.in[11] + l * 256;
        const int c = F.tid & 255, hf = F.tid >> 8;
        float w[31];
#pragma unroll
        for (int j = 0; j < 31; ++j) w[j] = cw[j * 256 + c];
        const float cbias = a.in[9][l * 256 + c];
        for (int it = F.wg; it < M / 32; it += F.G) {
            const int tok0 = it * 32, p0 = tok0 & (SEQ - 1); const bf16* zb = zs + (size_t)(tok0 - p0) * ZSW;
            for (int task = F.tid; task < 62 * 32; task += NWAVES * 64) {
                const int rr = task >> 5, ck = task & 31, p = p0 - 15 + rr; f32x4 o0 = (f32x4){0.f, 0.f, 0.f, 0.f}, o1 = o0;
                if (p >= 0 && p < SEQ) { float av[8], gv[8]; unpack8(*(const GAS v4u*)(zb + (size_t)p * ZSW + 1280 + ck * 8), av); unpack8(*(const GAS v4u*)(zb + (size_t)p * ZSW + 1536 + ck * 8), gv);
                    o0 = (f32x4){av[0] * sigm(gv[0]), av[1] * sigm(gv[1]), av[2] * sigm(gv[2]), av[3] * sigm(gv[3])}; o1 = (f32x4){av[4] * sigm(gv[4]), av[5] * sigm(gv[5]), av[6] * sigm(gv[6]), av[7] * sigm(gv[7])}; }
                *(LAS f32x4*)(sbuf + rr * 256 + ck * 8) = o0; *(LAS f32x4*)(sbuf + rr * 256 + ck * 8 + 4) = o1;
            }
            __syncthreads();
            float acc[16];
#pragma unroll
            for (int i = 0; i < 16; ++i) acc[i] = 0.f;
#pragma unroll
            for (int j = 0; j < 46; ++j) { const float v = sbuf[(hf * 16 + j) * 256 + c];
#pragma unroll
                for (int i = 0; i < 16; ++i) { if (j - i >= 0 && j - i < 31) acc[i] += w[j - i] * v; } }
#pragma unroll
            for (int i = 0; i < 16; ++i) ybuf[(hf * 16 + i) * 256 + c] = acc[i] + cbias;
            __syncthreads();
#pragma unroll
            for (int q = 0; q < 4; ++q) { const int t = F.wave * 4 + q; f32x4 y = *(const LAS f32x4*)(ybuf + t * 256 + 4 * F.lane);
                const float mean = wave_sum((y.x + y.y) + (y.z + y.w)) * (1.f / 256.f); y = y - mean;
                const float rstd = 1.f / sqrtf(wave_sum((y.x * y.x + y.y * y.y) + (y.z * y.z + y.w * y.w)) * (1.f / 256.f) + LN_EPS);
                const f32x4 o = y * rstd * *(const f32x4*)(lg + 4 * F.lane) + *(const f32x4*)(lb + 4 * F.lane);
                v2u wv; wv.x = cvt_pk_bf16(o.x * sigm(o.x), o.y * sigm(o.y)); wv.y = cvt_pk_bf16(o.z * sigm(o.z), o.w * sigm(o.w));
                *(GAS v2u*)(br + (size_t)(tok0 + t) * 1024 + 512 + 4 * F.lane) = wv; }
            __syncthreads();
        }
    }
    const int gt = F.wg * (NWAVES * 64) + F.tid, NT_ = F.G * NWAVES * 64;
    {
        const float* qg = a.in[5] + l * 64; const float* kg = a.in[6] + l * 64; const float* rope = (const float*)(a.ws + WS_ROPE);
        for (int it = gt; it < M * 6; it += NT_) {
            const int tok = it / 6, hh = it - tok * 6; const bf16* src = zs + (size_t)tok * ZSW + hh * 64;
            float x[64]; float ss = 0.f;
#pragma unroll
            for (int q = 0; q < 8; ++q) { float t8[8]; unpack8(*(const GAS v4u*)(src + q * 8), t8);
#pragma unroll
                for (int i = 0; i < 8; ++i) { x[q * 8 + i] = t8[i]; ss += t8[i] * t8[i]; } }
            const float rinv = 1.f / sqrtf(ss * (1.f / 64.f) + RMS_EPS); const float* gn = hh < 4 ? qg : kg; const float sc = hh < 4 ? QSCALE : 1.f;
#pragma unroll
            for (int i = 0; i < 64; ++i) x[i] *= rinv * gn[i] * sc;
            const int pos = tok & (SEQ - 1); const float* tr = rope + (pos >> 6) * 32; const float* tc = rope + (128 + (pos & 63)) * 32;
            float o[64];
#pragma unroll
            for (int i = 0; i < 16; ++i) { const float cr = tr[i], sr = tr[16 + i], cc = tc[i], sn = tc[16 + i];
                o[i] = x[i] * cr - x[16 + i] * sr; o[16 + i] = x[16 + i] * cr + x[i] * sr; o[32 + i] = x[32 + i] * cc - x[48 + i] * sn; o[48 + i] = x[48 + i] * cc + x[32 + i] * sn; }
            bf16* dst = hh < 4 ? qn + (size_t)tok * 256 + hh * 64 : kn + (size_t)tok * 128 + (hh - 4) * 64;
#pragma unroll
            for (int q = 0; q < 8; ++q) { float t8[8];
#pragma unroll
                for (int i = 0; i < 8; ++i) t8[i] = o[q * 8 + i];
                *(GAS v4u*)(dst + q * 8) = pack8(t8); }
        }
    }
    {
        const float* scw = a.in[7] + l * 3 * 256;
        for (int it = gt; it < M * 32; it += NT_) {
            const int tok = it >> 5, ch = (it & 31) * 8, pos = tok & (SEQ - 1); float acc[8];
#pragma unroll
            for (int i = 0; i < 8; ++i) acc[i] = 0.f;
#pragma unroll
            for (int j = -1; j <= 1; ++j) { const int p = pos + j;
                if (p >= 0 && p < SEQ) { float cg[8], u[8]; unpack8(*(const GAS v4u*)(zs + (size_t)(tok + j) * ZSW + 768 + ch), cg); unpack8(*(const GAS v4u*)(zs + (size_t)(tok + j) * ZSW + 1024 + ch), u);
#pragma unroll
                    for (int i = 0; i < 8; ++i) acc[i] += scw[(j + 1) * 256 + ch + i] * (cg[i] * u[i]); } }
            float bg[8]; unpack8(*(const GAS v4u*)(zs + (size_t)tok * ZSW + 512 + ch), bg);
#pragma unroll
            for (int i = 0; i < 8; ++i) acc[i] *= bg[i];
            *(GAS v4u*)(br + (size_t)tok * 1024 + 256 + ch) = pack8(acc);
        }
    }
    {
        for (int it = gt; it < M * 32; it += NT_) {
            const int tok = it >> 5, ch = (it & 31) * 8, pos = tok & (SEQ - 1), grp = ch >> 6, w = 2 << grp;
            const int lo = (pos - (w >> 1)) > 0 ? (pos - (w >> 1)) : 0, hi = (pos + (w - 1 - (w >> 1))) < (SEQ - 1) ? (pos + (w - 1 - (w >> 1))) : (SEQ - 1);
            float s[8];
#pragma unroll
            for (int i = 0; i < 8; ++i) s[i] = 0.f;
            for (int p = lo; p <= hi; ++p) { float u[8]; unpack8(*(const GAS v4u*)(zs + (size_t)(tok - pos + p) * ZSW + 1792 + ch), u);
#pragma unroll
                for (int i = 0; i < 8; ++i) s[i] += u[i]; }
            const float inv = 1.f / (float)(hi - lo + 1); float uc[8]; unpack8(*(const GAS v4u*)(zs + (size_t)tok * ZSW + 1792 + ch), uc);
#pragma unroll
            for (int i = 0; i < 8; ++i) s[i] = s[i] * inv - uc[i];
            *(GAS v4u*)(br + (size_t)tok * 1024 + 768 + ch) = pack8(s);
        }
    }
}

__device__ __forceinline__ void phase_ln_router(Frame& F, const Args& a, int l) {
    LAS float* wrT = (LAS float*)(F.lds + RING_OFF);
    LAS unsigned* hist = (LAS unsigned*)(F.lds + HIST_OFF); LAS float* lgs = (LAS float*)(F.lds + LG_OFF) + F.wave * 64;
    const float* wr = a.in[18] + (size_t)l * D * NE; const float* brt = a.in[19] + l * NE;
    for (int idx = F.tid; idx < NE * D; idx += NWAVES * 64) { const int e = idx >> 10, d = idx & 1023; wrT[idx] = wr[d * NE + e]; }
    if (F.tid < NE) hist[F.tid] = 0u;
    __syncthreads();
    float* H = a.out; bf16* hb = (bf16*)(a.ws + WS_HB); int* topE = (int*)(a.ws + WS_TOPE); float* topW = (float*)(a.ws + WS_TOPW); int* topR = (int*)(a.ws + WS_TOPR);
    const float* g1 = a.in[16] + l * D; const float* b1 = a.in[17] + l * D;
    const int TPW = M / F.G, tok_lo = F.wg * TPW;
    for (int r0 = F.wave * 2; r0 < TPW; r0 += NWAVES * 2) {
        const int tokA = tok_lo + r0;
        f32x4 v[2][4];
#pragma unroll
        for (int rr = 0; rr < 2; ++rr) {
#pragma unroll
            for (int j = 0; j < 4; ++j) v[rr][j] = *(const f32x4*)(H + (size_t)(tokA + rr) * D + 4 * F.lane + 256 * j);
            ln16(v[rr], g1, b1, F.lane); store_row(v[rr], H + (size_t)(tokA + rr) * D, hb + (size_t)(tokA + rr) * D, F.lane); }
        float p0[32], p1[32];
#pragma unroll
        for (int e = 0; e < 32; ++e) { float s0 = 0.f, s1 = 0.f;
#pragma unroll
            for (int j = 0; j < 4; ++j) { const f32x4 w4 = *(const LAS f32x4*)(wrT + e * 1024 + 256 * j + 4 * F.lane);
                s0 += (v[0][j].x * w4.x + v[0][j].y * w4.y) + (v[0][j].z * w4.z + v[0][j].w * w4.w); s1 += (v[1][j].x * w4.x + v[1][j].y * w4.y) + (v[1][j].z * w4.z + v[1][j].w * w4.w); }
            p0[e] = s0; p1[e] = s1; }
#define RT_STEP(OFF, HALFN) { const bool up = (F.lane & (OFF)) != 0; _Pragma("unroll") for (int i = 0; i < (HALFN); ++i) { \
            const float k0 = up ? p0[i + (HALFN)] : p0[i], s0 = up ? p0[i] : p0[i + (HALFN)]; p0[i] = k0 + __shfl_xor(s0, (OFF)); \
            const float k1 = up ? p1[i + (HALFN)] : p1[i], s1 = up ? p1[i] : p1[i + (HALFN)]; p1[i] = k1 + __shfl_xor(s1, (OFF)); } }
        RT_STEP(32, 16) RT_STEP(16, 8) RT_STEP(8, 4) RT_STEP(4, 2) RT_STEP(2, 1)
#undef RT_STEP
        const int le = F.lane >> 1; const float be = brt[le];
        const float lgA = p0[0] + __shfl_xor(p0[0], 1) + be, lgB = p1[0] + __shfl_xor(p1[0], 1) + be;
        if ((F.lane & 1) == 0) { lgs[le] = lgA; lgs[32 + le] = lgB; }
        LDS_WAIT(); asm volatile("" ::: "memory");
        const int rsel = F.lane >> 5; const LAS float* lr = lgs + rsel * 32;
        float v0 = -INFINITY, v1 = -INFINITY, v2 = -INFINITY, v3 = -INFINITY; int i0 = 0, i1 = 0, i2 = 0, i3 = 0;
#pragma unroll
        for (int e = 0; e < 32; ++e) { const float x = lr[e];
            if (x > v3) { if (x > v0) { v3 = v2; i3 = i2; v2 = v1; i2 = i1; v1 = v0; i1 = i0; v0 = x; i0 = e; }
                          else if (x > v1) { v3 = v2; i3 = i2; v2 = v1; i2 = i1; v1 = x; i1 = e; }
                          else if (x > v2) { v3 = v2; i3 = i2; v2 = x; i2 = e; }
                          else { v3 = x; i3 = e; } } }
        LDS_WAIT(); asm volatile("" ::: "memory");
        if ((F.lane & 31) == 0) {
            const float e1 = __expf(v1 - v0), e2 = __expf(v2 - v0), e3 = __expf(v3 - v0), inv = 1.f / (1.f + e1 + e2 + e3); const int tok = tokA + rsel;
            const unsigned k0 = __hip_atomic_fetch_add(hist + i0, 1u, __ATOMIC_RELAXED, __HIP_MEMORY_SCOPE_WORKGROUP), k1 = __hip_atomic_fetch_add(hist + i1, 1u, __ATOMIC_RELAXED, __HIP_MEMORY_SCOPE_WORKGROUP);
            const unsigned k2 = __hip_atomic_fetch_add(hist + i2, 1u, __ATOMIC_RELAXED, __HIP_MEMORY_SCOPE_WORKGROUP), k3 = __hip_atomic_fetch_add(hist + i3, 1u, __ATOMIC_RELAXED, __HIP_MEMORY_SCOPE_WORKGROUP);
            *(int4*)(topE + tok * 4) = make_int4(i0, i1, i2, i3); *(float4*)(topW + tok * 4) = make_float4(inv, e1 * inv, e2 * inv, e3 * inv); *(int4*)(topR + tok * 4) = make_int4((int)k0, (int)k1, (int)k2, (int)k3);
        }
    }
    __syncthreads();
    if (F.tid < NE) { const unsigned base = __hip_atomic_fetch_add(F.ctl + CW_CNT + 32 * l + F.tid, hist[F.tid], RLX_AGENT); ((int*)(a.ws + WS_WGB))[F.wg * NE + F.tid] = (int)base; }
}
__device__ __forceinline__ void build_moe_tab(Frame& F, int l, int nct) {
    LAS int* tab = (LAS int*)(F.lds + TAB_OFF);
    if (F.tid == 0) { int cu = 0, ts = 0;
        for (int e = 0; e < NE; ++e) { const int cnt = (int)__hip_atomic_load(F.ctl + CW_CNT + 32 * l + e, RLX_AGENT), nt = (cnt + 255) >> 8; tab[e] = cu; tab[33 + e] = ts; cu += nt * nct; ts += nt; }
        tab[32] = cu; tab[65] = ts; }
    __syncthreads();
}
__device__ __forceinline__ void phase_scatter(Frame& F, const Args& a, int l) {
    build_moe_tab(F, l, 8);
    const LAS int* tab = (const LAS int*)(F.lds + TAB_OFF);
    const bf16* hb = (const bf16*)(a.ws + WS_HB); bf16* xs = (bf16*)(a.ws + WS_XS); const int* topE = (const int*)(a.ws + WS_TOPE); int* topR = (int*)(a.ws + WS_TOPR); const int* wgb = (const int*)(a.ws + WS_WGB) + F.wg * NE;
    const int TPW = M / F.G, tok_lo = F.wg * TPW;
    for (int r = F.wave; r < TPW; r += NWAVES) {
        const int tok = tok_lo + r; int pos = 0;
        if (F.lane < 4) { const int e = topE[tok * 4 + F.lane]; pos = tab[33 + e] * 256 + wgb[e] + topR[tok * 4 + F.lane]; }
        const v4u x0 = *(const GAS v4u*)(hb + (size_t)tok * D + 8 * F.lane), x1 = *(const GAS v4u*)(hb + (size_t)tok * D + 512 + 8 * F.lane);
#pragma unroll
        for (int k = 0; k < 4; ++k) { const int pk = __shfl(pos, k); *(GAS v4u*)(xs + (size_t)pk * D + 8 * F.lane) = x0; *(GAS v4u*)(xs + (size_t)pk * D + 512 + 8 * F.lane) = x1; }
        if (F.lane < 4) topR[tok * 4 + F.lane] = pos;
    }
}
__device__ __forceinline__ void phase_combine(Frame& F, const Args& a, int l) {
    float* H = a.out; bf16* hb = (bf16*)(a.ws + WS_HB); const bf16* Y = (const bf16*)(a.ws + WS_Y); const float* topW = (const float*)(a.ws + WS_TOPW); const int* topR = (const int*)(a.ws + WS_TOPR);
    const float* g2 = a.in[24] + l * D; const float* b2 = a.in[25] + l * D;
    const int gw = F.wg * NWAVES + F.wave, NGW = F.G * NWAVES;
    for (int tok = gw; tok < M; tok += NGW) {
        const int4 ps = *(const int4*)(topR + tok * 4); const float4 ws = *(const float4*)(topW + tok * 4);
        const int pk[4] = {ps.x, ps.y, ps.z, ps.w}; const float wk[4] = {ws.x, ws.y, ws.z, ws.w};
        f32x4 v[4];
#pragma unroll
        for (int j = 0; j < 4; ++j) { v[j] = *(const f32x4*)(H + (size_t)tok * D + 4 * F.lane + 256 * j) * DN_ALPHA;
#pragma unroll
            for (int k = 0; k < 4; ++k) { const v2u y = *(const GAS v2u*)(Y + (size_t)pk[k] * D + 4 * F.lane + 256 * j); v[j].x += wk[k] * bflo(y.x); v[j].y += wk[k] * bfhi(y.x); v[j].z += wk[k] * bflo(y.y); v[j].w += wk[k] * bfhi(y.y); } }
        ln16(v, g2, b2, F.lane); store_row(v, H + (size_t)tok * D, hb + (size_t)tok * D, F.lane);
    }
}

__global__ void __launch_bounds__(NWAVES * 64, 2) mk_fwd(Args args) {
    extern __shared__ __attribute__((aligned(16))) unsigned char lds[];
    Frame F;
    F.lds = (LAS unsigned char*)lds; F.MISC = (volatile LAS unsigned*)(F.lds + MISC_OFF);
    F.tid = threadIdx.x; F.lane = F.tid & 63; F.wave = __builtin_amdgcn_readfirstlane(F.tid >> 6);
    F.G = gridDim.x; F.wg = blockIdx.x; { const int bx = blockIdx.x; F.vcu = (F.G % 8 == 0) ? (bx % 8) * (F.G / 8) + bx / 8 : bx; }
    F.ctl = (gu32*)(args.ws + WS_CTL);
    for (int u = F.tid; u < (LDS_BYTES - LDSCTL_OFF) / 4; u += NWAVES * 64) ((LAS unsigned*)(F.lds + LDSCTL_OFF))[u] = 0u;
    __syncthreads();
#if MK_ONE_LAUNCH
    XcdBarrier bar = xcd_barrier_post((unsigned*)(F.ctl + CW_BAR), F.MISC + 8);
#define GRID_BAR() xcd_barrier(bar)
#else
#define GRID_BAR() do { } while (0)
#endif
    const int lo = args.ph_lo, hi = args.ph_hi;
#ifndef PH_MASK
#define PH_MASK 0xfff
#endif
#define IN(k) (lo <= (k) && (k) < hi)
#define ON(s) (((PH_MASK) >> (s)) & 1)
#define FRESH() asm volatile("" : "+v"(F.tid), "+v"(F.lane))
#define SEAM(k) do { if (IN((k) + 1)) GRID_BAR(); } while (0)
    unsigned char* ws = args.ws;
    if (ON(11) && IN(0)) { FRESH(); phase_prologue(F, args); SEAM(0); }
#pragma unroll 1
    for (int l = 0; l < DEPTH; ++l) {
        const int pb = 1 + NSUB * l; unsigned char* wl = ws + WS_W0 + (size_t)l * W_LAYER;
        if (ON(0) && IN(pb + 0)) { FRESH();
            pg8::Gemm g{(const pg8::bf16_t*)(ws + WS_HB), (const pg8::bf16_t*)(wl + WO_INS), M, ZSW, D, D, D}; pg8::StaticOrder S; S.init(M, ZSW, F.G, F.wg);
            pg8::EpiBf16<0> E{(pg8::bf16_t*)(ws + WS_ZS), ZSW, args.in[4] + l * IN_COLS, 0, 0, 1.f};
            pg8::gemm_phase<pg8::EpiBf16<0>, pg8::StaticOrder, true, true>(F.lds + RING_OFF, g, S, E); SEAM(pb + 0); }
        if (ON(1) && IN(pb + 1)) { FRESH(); phase_prep(F, args, l); SEAM(pb + 1); }
        if (ON(2) && IN(pb + 2)) { FRESH();
            const attn_body::AttnTensors AT{(const attn_body::bf16*)(ws + WS_QN), (const attn_body::bf16*)(ws + WS_KN), (const attn_body::bf16*)(ws + WS_ZS) + 384, (attn_body::bf16*)(ws + WS_BR)};
            const attn_body::StaticOrder S(F.vcu);
            attn_body::attn_phase<attn_body::StaticOrder>((char*)lds + RING_OFF, AT, S); SEAM(pb + 2); }
        if (ON(3) && IN(pb + 3)) { FRESH();
            pg8::Gemm g{(const pg8::bf16_t*)(ws + WS_BR), (const pg8::bf16_t*)(wl + WO_B), M, 4096, 256, D, 256}; pg8::BranchOrder S; S.init(M, 4096, F.G, F.wg);
            pg8::EpiBf16<0> E{(pg8::bf16_t*)(ws + WS_P), 4096, nullptr, 0, 0, 1.f};
            pg8::gemm_phase<pg8::EpiBf16<0>, pg8::BranchOrder, true, true>(F.lds + RING_OFF, g, S, E); SEAM(pb + 3); }
        if (ON(4) && IN(pb + 4)) { FRESH();
            pg8::Gemm g{(const pg8::bf16_t*)(ws + WS_HB), (const pg8::bf16_t*)(wl + WO_G), M, 4096, D, D, D}; pg8::StaticOrder S; S.init(M, 4096, F.G, F.wg);
            pg8::EpiGate E{(const pg8::bf16_t*)(ws + WS_P), args.in[4] + l * IN_COLS + 2048, (pg8::bf16_t*)(ws + WS_MG)};
            pg8::gemm_phase<pg8::EpiGate, pg8::StaticOrder, true, true>(F.lds + RING_OFF, g, S, E); SEAM(pb + 4); }
        if (ON(5) && IN(pb + 5)) { FRESH();
            pg8::Gemm g{(const pg8::bf16_t*)(ws + WS_MG), (const pg8::bf16_t*)(wl + WO_O), M, D, D, D, D}; pg8::StaticOrder S; S.init(M, D, F.G, F.wg);
            pg8::EpiResid E{args.out, DN_ALPHA};
            pg8::gemm_phase<pg8::EpiResid, pg8::StaticOrder, true, true>(F.lds + RING_OFF, g, S, E); SEAM(pb + 5); }
        if (ON(6) && IN(pb + 6)) { FRESH(); phase_ln_router(F, args, l); SEAM(pb + 6); }
        if (ON(7) && IN(pb + 7)) { FRESH(); phase_scatter(F, args, l); SEAM(pb + 7); }
        if (ON(8) && IN(pb + 8)) { FRESH();
            build_moe_tab(F, l, 8);
            pg8::Gemm g{(const pg8::bf16_t*)(ws + WS_XS), (const pg8::bf16_t*)(wl + WO_GU), RMAX, 2048 * NE, D, D, D}; pg8::MoeOrder S{(const LAS int*)(F.lds + TAB_OFF), 8, F.G, F.wg};
            pg8::EpiSwiglu E{(pg8::bf16_t*)(ws + WS_HA), args.in[21] + (size_t)l * NE * 2048};
            pg8::gemm_phase<pg8::EpiSwiglu, pg8::MoeOrder, true, true>(F.lds + RING_OFF, g, S, E); SEAM(pb + 8); }
        if (ON(9) && IN(pb + 9)) { FRESH();
            build_moe_tab(F, l, 4);
            pg8::Gemm g{(const pg8::bf16_t*)(ws + WS_HA), (const pg8::bf16_t*)(wl + WO_D), RMAX, D * NE, D, D, D}; pg8::MoeOrder S{(const LAS int*)(F.lds + TAB_OFF), 4, F.G, F.wg};
            pg8::EpiDown E{(pg8::bf16_t*)(ws + WS_Y), args.in[23] + (size_t)l * NE * D};
            pg8::gemm_phase<pg8::EpiDown, pg8::MoeOrder, true, true>(F.lds + RING_OFF, g, S, E); SEAM(pb + 9); }
        if (ON(10) && IN(pb + 10)) { FRESH(); phase_combine(F, args, l); SEAM(pb + 10); }
    }
#undef IN
#undef SEAM
}

extern "C" void kernel_launch(void* const* d_in, const int* in_sizes, int n_in, void* d_out, int out_size, void* d_ws, size_t ws_size, hipStream_t stream) {
    static int grid = 0;
    if (grid == 0) {
        if (n_in != 26 || in_sizes[0] != M * D || out_size != M * D || ws_size < WS_END) { fprintf(stderr, "kernel_launch: unexpected shapes (n_in %d, in0 %d, out %d, ws %zu < %zu?); nothing launched\n", n_in, n_in > 0 ? in_sizes[0] : -1, out_size, ws_size, (size_t)WS_END); grid = -1; return; }
        if (hipFuncSetAttribute((const void*)mk_fwd, hipFuncAttributeMaxDynamicSharedMemorySize, LDS_BYTES) != hipSuccess) { fprintf(stderr, "kernel_launch: hipFuncSetAttribute failed\n"); grid = -1; return; }
        int per_cu = 0;
        if (hipOccupancyMaxActiveBlocksPerMultiprocessor(&per_cu, (const void*)mk_fwd, NWAVES * 64, LDS_BYTES) != hipSuccess || per_cu < 1) fprintf(stderr, "kernel_launch: note: occupancy query reports %d workgroups per CU\n", per_cu);
        (void)hipGetLastError();
        grid = 256;
    }
    if (grid < 0) return;
    if (hipMemsetAsync((char*)d_ws + WS_CTL, 0, CTL_ZERO_BYTES, stream) != hipSuccess) { fprintf(stderr, "kernel_launch: memset failed\n"); return; }
    Args a{};
    for (int i = 0; i < 26; ++i) a.in[i] = (const float*)d_in[i];
    a.out = (float*)d_out; a.ws = (unsigned char*)d_ws;
#if MK_ONE_LAUNCH
    a.ph_lo = 0; a.ph_hi = NPH;
    hipLaunchKernelGGL(mk_fwd, dim3(grid), dim3(NWAVES * 64), LDS_BYTES, stream, a);
#else
    for (int p = 0; p < NPH; ++p) { a.ph_lo = p; a.ph_hi = p + 1; hipLaunchKernelGGL(mk_fwd, dim3(grid), dim3(NWAVES * 64), LDS_BYTES, stream, a); }
#endif
    const hipError_t le = hipPeekAtLastError();
    if (le != hipSuccess) fprintf(stderr, "kernel_launch: launch failed: %s\n", hipGetErrorName(le));
}
```

```cpp
#include <hip/hip_runtime.h>
#include <cstdio>
#include <cstdint>
#include <hip/hip_runtime.h>
#include <cstdio>
#include <cstdint>
namespace pg8 {
#define PG8_LAS __attribute__((address_space(3)))
typedef unsigned short bf16_t;
typedef short bf16x8 __attribute__((ext_vector_type(8)));
typedef float f32x4 __attribute__((ext_vector_type(4)));
typedef unsigned u32x4 __attribute__((ext_vector_type(4)));
constexpr int BM = 256, BK = 64, HALF = 128, HTB = HALF * BK * 2  , STAGE_BYTES = 8 * HTB, NXCD = 8, WGM = 8;

__host__ __device__ __forceinline__ int lds_byte(int r, int c) { const int st = (r >> 4) * 2 + (c >> 5), rr = r & 15, cc = c & 31, ob = rr * 64 + cc * 2; return st * 1024 + (ob ^ (((ob >> 9) & 1) << 5)); }
__host__ __device__ __forceinline__ void stage_rc(int b, int& R, int& C) { const int st = b / 1024, sb = b % 1024, swz = sb ^ (((sb >> 9) & 1) << 5); R = (st >> 1) * 16 + swz / 64; C = (st & 1) * 32 + (swz % 64) / 2; }
__host__ __device__ __forceinline__ int perm32(int rho) { const int n = rho >> 4, i = rho & 15; return 8 * (i >> 2) + 4 * n + (i & 3); }

struct Unit { int pm, pn, ka; };
struct Gemm { const bf16_t* A; const bf16_t* Bt; int M, N, K, lda, ldb; };

struct StaticOrder {
    int nM, nN, nwg, G, c;
    __host__ __device__ void init(int M, int N, int G_, int c_) { nM = M / BM; nN = N / BM; nwg = nM * nN; G = G_; c = c_; }
    __host__ __device__ bool next(int i, Unit& u) const {
        const long L = (long)i * G + c; if (L >= nwg) return false;
        int wgid = (int)L; { const int q = nwg / NXCD, r = nwg % NXCD, xcd = wgid % NXCD, off = wgid / NXCD; wgid = (xcd < r ? xcd * (q + 1) : r * (q + 1) + (xcd - r) * q) + off; }
        const int nig = WGM * nN, gid = wgid / nig, fm = gid * WGM, gsz = (nM - fm) < WGM ? (nM - fm) : WGM;
        u.pm = fm + ((wgid % nig) % gsz); u.pn = (wgid % nig) / gsz; u.ka = 0; return true;
    }
    __device__ __forceinline__ void a_ready(const Unit&) const {}
    __device__ __forceinline__ void done(const Unit&) const {}
};

__device__ __forceinline__ unsigned cvt_pk_bf16(float lo, float hi) { unsigned r; asm volatile("v_cvt_pk_bf16_f32 %0, %1, %2" : "=v"(r) : "v"(lo), "v"(hi)); return r; }
typedef float f32x2 __attribute__((ext_vector_type(2)));
__device__ __forceinline__ f32x2 gelu_pk(f32x2 v) {
    const f32x2 av = __builtin_elementwise_abs(v), d = av * 0.2316418882f + 1.0f;
    f32x2 t; t.x = __builtin_amdgcn_rcpf(d.x); t.y = __builtin_amdgcn_rcpf(d.y);
    f32x2 q = t * 0.5307027145f + (-0.7265760135f); q = q * t + 0.7107068705f; q = q * t + (-0.142248368f); q = q * t + 0.127414796f; q = q * t;
    const f32x2 s = (v * v) * (-0.72134752044f);
    f32x2 e; e.x = __builtin_amdgcn_exp2f(s.x); e.y = __builtin_amdgcn_exp2f(s.y);
    const f32x2 m = v * (q * e), r = v - m;
    f32x2 o; o.x = v.x < 0.f ? m.x : r.x; o.y = v.y < 0.f ? m.y : r.y; return o;
}

template <int ACT  > struct EpiBf16 {
    static constexpr bool PERM = true, AFTER_DRAIN = false; static_assert(ACT == 0 || ACT == 1, "EpiBf16: ACT is 0 (none) or 1 (gelu_pk)");
    bf16_t* O; int ldc; const float* bias; int split_cols; size_t split_stride; float scale0;
    __device__ __forceinline__ void operator()(const f32x4 (&acc)[2][2][4][2], const Unit& u, int wr, int wc, int fr, int fq) const {
        const int row0 = u.pm * BM + wr * 64 + fr; int colt = u.pn * BM; bf16_t* base = O;
        float sc = 1.f; if (split_cols) { const int t = colt / split_cols; base += (size_t)t * split_stride; colt -= t * split_cols; if (t == 0) sc = scale0; }
        const int col0 = colt + wc * 32 + 8 * fq, bcol0 = u.pn * BM + wc * 32 + 8 * fq;
        f32x4 bv[2][2];
#pragma unroll
        for (int bj = 0; bj < 2; ++bj)
#pragma unroll
            for (int n = 0; n < 2; ++n) bv[bj][n] = bias ? *(const f32x4*)(bias + bcol0 + bj * HALF + 4 * n) : (f32x4){0.f, 0.f, 0.f, 0.f};
#pragma unroll
        for (int ai = 0; ai < 2; ++ai)
#pragma unroll
            for (int m = 0; m < 4; ++m) { bf16_t* rowp = base + (size_t)(row0 + ai * HALF + m * 16) * ldc + col0;
#pragma unroll
                for (int bj = 0; bj < 2; ++bj) { f32x4 v0 = acc[ai][bj][m][0] + bv[bj][0], v1 = acc[ai][bj][m][1] + bv[bj][1];
                    if (ACT == 1) { f32x2 a = gelu_pk((f32x2){v0[0], v0[1]}), b = gelu_pk((f32x2){v0[2], v0[3]}), c = gelu_pk((f32x2){v1[0], v1[1]}), d = gelu_pk((f32x2){v1[2], v1[3]});
                        v0 = (f32x4){a.x, a.y, b.x, b.y}; v1 = (f32x4){c.x, c.y, d.x, d.y}; }
                    v0 = v0 * sc; v1 = v1 * sc; u32x4 w; w.x = cvt_pk_bf16(v0[0], v0[1]); w.y = cvt_pk_bf16(v0[2], v0[3]); w.z = cvt_pk_bf16(v1[0], v1[1]); w.w = cvt_pk_bf16(v1[2], v1[3]);
                    *(u32x4*)(rowp + bj * HALF) = w; } }
    }
};

template <class Epi, class Sched, bool ALIGN_EPI = false, bool SP2 = false>
__device__ __forceinline__ void gemm_phase(PG8_LAS unsigned char* lds, const Gemm g, const Sched& S, const Epi& E) {
    int tid_ = threadIdx.x; asm volatile("" : "+v"(tid_));
    const int tid = tid_, wid = __builtin_amdgcn_readfirstlane(tid >> 6), lane = tid & 63, wr = wid >> 2, wc = wid & 3, fr = lane & 15, fq = lane >> 4;
    const int K = g.K, nt = K / BK;
    unsigned voffA[2], voffB[2];
#pragma unroll
    for (int i = 0; i < 2; ++i) { int R, C; stage_rc(tid * 16 + i * 8192, R, C); const int Rb = Epi::PERM ? ((R & ~31) + perm32(R & 31)) : R;
        voffA[i] = (unsigned)(R * g.lda + C) * 2u; voffB[i] = (unsigned)(Rb * g.ldb + C) * 2u; }
    const size_t kstep = (size_t)(BK * 2);
    const size_t hstepA = (size_t)HALF * g.lda * 2, hstepB = (size_t)HALF * g.ldb * 2;
    const size_t tstepA = 2 * hstepA, tstepB = 2 * hstepB;
    const unsigned ldsw = (unsigned)wid * 1024u;
    const int aoff = lds_byte(wr * 64 + fr, fq * 8), boff = lds_byte(wc * 32 + fr, fq * 8);
#define PG8_SA(b, h) (((b) * 2 + (h)) * HTB)
#define PG8_SB(b, h) ((4 + (b) * 2 + (h)) * HTB)
#define PG8_STAGE(bufoff, gbase, voff) do { _Pragma("unroll") for (int _i = 0; _i < 2; ++_i) \
        __builtin_amdgcn_global_load_lds((const unsigned*)((const char*)(gbase) + (voff)[_i]), (PG8_LAS unsigned*)(lds + (bufoff) + ldsw + _i * 8192), 16, 0, 0); } while (0)
#define PG8_LDA(dst, b, h) do { _Pragma("unroll") for (int m = 0; m < 4; ++m) _Pragma("unroll") for (int k = 0; k < 2; ++k) dst[m][k] = *(const PG8_LAS bf16x8*)(lds + PG8_SA(b, h) + aoff + m * 2048 + k * 1024); } while (0)
#define PG8_LDB(dst, b, h) do { _Pragma("unroll") for (int n = 0; n < 2; ++n) _Pragma("unroll") for (int k = 0; k < 2; ++k) dst[n][k] = *(const PG8_LAS bf16x8*)(lds + PG8_SB(b, h) + boff + n * 2048 + k * 1024); } while (0)
#define PG8_MMA(ai, bj, At, Bt) do { __builtin_amdgcn_s_setprio(1); _Pragma("unroll") for (int m = 0; m < 4; ++m) _Pragma("unroll") for (int n = 0; n < 2; ++n) _Pragma("unroll") for (int k = 0; k < 2; ++k) \
        acc[ai][bj][m][n] = __builtin_amdgcn_mfma_f32_16x16x32_bf16(Bt[n][k], At[m][k], acc[ai][bj][m][n], 0, 0, 0); __builtin_amdgcn_s_setprio(0); } while (0)
#define PG8_WAIT_V(n) asm volatile("s_waitcnt vmcnt(" #n ")" ::: "memory")
#define PG8_WAIT_L(n) asm volatile("s_waitcnt lgkmcnt(" #n ")" ::: "memory")
#define PG8_BAR __builtin_amdgcn_s_barrier()
#define PG8_SCHED __builtin_amdgcn_sched_barrier(0)
    Unit cur, nxt; int ui = 0;
    if (!S.next(0, cur)) return;
    f32x4 acc[2][2][4][2];
#pragma unroll
    for (int a = 0; a < 2; ++a)
#pragma unroll
        for (int b = 0; b < 2; ++b)
#pragma unroll
            for (int m = 0; m < 4; ++m)
#pragma unroll
                for (int n = 0; n < 2; ++n) acc[a][b][m][n] = (f32x4){0.f, 0.f, 0.f, 0.f};
    bf16x8 At[4][2], B0[2][2], B1[2][2];
    const char* cA = (const char*)g.A + (size_t)cur.pm * tstepA + (size_t)cur.ka * 2; const char* cB = (const char*)g.Bt + (size_t)cur.pn * tstepB;
    S.a_ready(cur);
    if constexpr (SP2) {
        PG8_STAGE(PG8_SB(0, 0), cB, voffB); PG8_STAGE(PG8_SB(0, 1), cB + hstepB, voffB); PG8_STAGE(PG8_SA(0, 0), cA, voffA); PG8_STAGE(PG8_SA(0, 1), cA + hstepA, voffA);
        if (wr == 1) PG8_BAR;
        PG8_WAIT_V(2); PG8_BAR;
        PG8_STAGE(PG8_SB(1, 0), cB + kstep, voffB); PG8_STAGE(PG8_SA(1, 0), cA + kstep, voffA); PG8_STAGE(PG8_SB(1, 1), cB + hstepB + kstep, voffB);
        PG8_WAIT_V(6); PG8_BAR;
    } else {
        PG8_STAGE(PG8_SB(0, 0), cB, voffB); PG8_STAGE(PG8_SA(0, 0), cA, voffA); PG8_STAGE(PG8_SB(0, 1), cB + hstepB, voffB); PG8_STAGE(PG8_SA(0, 1), cA + hstepA, voffA);
        if (wr == 1) PG8_BAR;
        PG8_WAIT_V(4); PG8_BAR;
        PG8_STAGE(PG8_SB(1, 0), cB + kstep, voffB); PG8_STAGE(PG8_SA(1, 0), cA + kstep, voffA); PG8_STAGE(PG8_SB(1, 1), cB + hstepB + kstep, voffB);
        PG8_WAIT_V(6); PG8_BAR;
    }
    for (;;) {
        const bool has_next = S.next(ui + 1, nxt);
        const char* nA = has_next ? (const char*)g.A + (size_t)nxt.pm * tstepA + (size_t)nxt.ka * 2 : cA; const char* nB = has_next ? (const char*)g.Bt + (size_t)nxt.pn * tstepB : cB;
#pragma unroll 1
        for (int t = 0; t < nt; t += 2) {
            const bool last = (t == nt - 2);
            const char* a1 = cA + (size_t)(t + 1) * kstep;
            const char* a2 = last ? nA : cA + (size_t)(t + 2) * kstep; const char* b2 = last ? nB : cB + (size_t)(t + 2) * kstep;
            const char* a3 = a2 + kstep; const char* b3 = b2 + kstep;
            if (last && has_next) S.a_ready(nxt);
            if constexpr (SP2) {
            PG8_LDB(B0, 0, 0); PG8_LDB(B1, 0, 1); PG8_SCHED; PG8_LDA(At, 0, 0); PG8_STAGE(PG8_SA(1, 1), a1 + hstepA, voffA);
            PG8_WAIT_V(8); PG8_WAIT_L(0); PG8_BAR; PG8_MMA(0, 0, At, B0); PG8_MMA(0, 1, At, B1); PG8_BAR; PG8_SCHED;
            PG8_LDA(At, 0, 1); PG8_STAGE(PG8_SB(0, 0), b2, voffB); PG8_STAGE(PG8_SB(0, 1), b2 + hstepB, voffB); PG8_STAGE(PG8_SA(0, 0), a2, voffA);
            PG8_WAIT_V(8); PG8_WAIT_L(0); PG8_BAR; PG8_MMA(1, 0, At, B0); PG8_MMA(1, 1, At, B1); PG8_BAR; PG8_SCHED;
            PG8_LDB(B0, 1, 0); PG8_LDB(B1, 1, 1); PG8_SCHED; PG8_LDA(At, 1, 0); PG8_STAGE(PG8_SA(0, 1), a2 + hstepA, voffA);
            PG8_WAIT_V(8); PG8_WAIT_L(0); PG8_BAR; PG8_MMA(0, 0, At, B0); PG8_MMA(0, 1, At, B1); PG8_BAR; PG8_SCHED;
            PG8_LDA(At, 1, 1); PG8_STAGE(PG8_SB(1, 0), b3, voffB); PG8_STAGE(PG8_SB(1, 1), b3 + hstepB, voffB); PG8_STAGE(PG8_SA(1, 0), a3, voffA);
            PG8_WAIT_V(8); PG8_WAIT_L(0); PG8_BAR; PG8_MMA(1, 0, At, B0); PG8_MMA(1, 1, At, B1); PG8_BAR; PG8_SCHED;
            } else {
            PG8_LDB(B0, 0, 0); PG8_SCHED; PG8_LDA(At, 0, 0); PG8_STAGE(PG8_SA(1, 1), a1 + hstepA, voffA);
            PG8_WAIT_L(8); PG8_BAR; PG8_WAIT_L(0); PG8_MMA(0, 0, At, B0); PG8_BAR; PG8_SCHED;
            PG8_LDB(B1, 0, 1); PG8_STAGE(PG8_SB(0, 0), b2, voffB);
            PG8_BAR; PG8_WAIT_L(0); PG8_MMA(0, 1, At, B1); PG8_BAR;
            PG8_LDA(At, 0, 1); PG8_STAGE(PG8_SA(0, 0), a2, voffA);
            PG8_BAR; PG8_WAIT_L(0); PG8_MMA(1, 0, At, B0); PG8_BAR; PG8_SCHED;
            PG8_STAGE(PG8_SB(0, 1), b2 + hstepB, voffB);
            PG8_WAIT_V(6); PG8_BAR; PG8_MMA(1, 1, At, B1); PG8_BAR;
            PG8_LDB(B0, 1, 0); PG8_SCHED; PG8_LDA(At, 1, 0); PG8_STAGE(PG8_SA(0, 1), a2 + hstepA, voffA);
            PG8_WAIT_L(8); PG8_BAR; PG8_WAIT_L(0); PG8_MMA(0, 0, At, B0); PG8_BAR; PG8_SCHED;
            PG8_LDB(B1, 1, 1); PG8_STAGE(PG8_SB(1, 0), b3, voffB);
            PG8_BAR; PG8_WAIT_L(0); PG8_MMA(0, 1, At, B1); PG8_BAR;
            PG8_LDA(At, 1, 1); PG8_STAGE(PG8_SA(1, 0), a3, voffA);
            PG8_BAR; PG8_WAIT_L(0); PG8_MMA(1, 0, At, B0); PG8_BAR; PG8_SCHED;
            PG8_STAGE(PG8_SB(1, 1), b3 + hstepB, voffB);
            PG8_WAIT_V(6); PG8_BAR; PG8_MMA(1, 1, At, B1); PG8_BAR;
            }
        }
        if constexpr (ALIGN_EPI) { if (wr == 0) PG8_BAR; }
        if constexpr (!Epi::AFTER_DRAIN) { E(acc, cur, wr, wc, fr, fq); S.done(cur); }
        if (!has_next) break;
#pragma unroll
        for (int a = 0; a < 2; ++a)
#pragma unroll
            for (int b = 0; b < 2; ++b)
#pragma unroll
                for (int m = 0; m < 4; ++m)
#pragma unroll
                    for (int n = 0; n < 2; ++n) acc[a][b][m][n] = (f32x4){0.f, 0.f, 0.f, 0.f};
        cur = nxt; cA = nA; cB = nB; ++ui;
        if constexpr (ALIGN_EPI) { if (wr == 1) PG8_BAR; }
    }
    PG8_WAIT_V(0);
    if constexpr (!ALIGN_EPI) { if (wr == 0) PG8_BAR; }
    PG8_BAR;
    if constexpr (Epi::AFTER_DRAIN) { E.fused(acc, cur, wr, wc, fr, fq, lds, wid, lane); S.done(cur); }
#undef PG8_SA
#undef PG8_SB
#undef PG8_STAGE
#undef PG8_LDA
#undef PG8_LDB
#undef PG8_MMA
#undef PG8_WAIT_V
#undef PG8_WAIT_L
#undef PG8_BAR
#undef PG8_SCHED
}
}

#include <hip/hip_bf16.h>
#include <cmath>
namespace attn_body {
using bf16=__hip_bfloat16;
using bf16x8=__attribute__((ext_vector_type(8)))short;
using s16x4=__attribute__((ext_vector_type(4)))short;
using f32x16=__attribute__((ext_vector_type(16)))float;
using u32x4=__attribute__((ext_vector_type(4)))unsigned;
constexpr int BATCH=8,NHEAD=4,SEQ=8192,D=64;
constexpr int QP=256,KP=128,VP=2048,OP=1024;
constexpr int NW=8,QBLK=32,QB=QBLK*NW,KVBLK=64,NQB=SEQ/QB;
constexpr int ATTN_UNIT_ROWS=QB;
__device__ __forceinline__ int crow(int r,int hi){return (r&3)+8*(r>>2)+4*hi;}
#define SBAR() __builtin_amdgcn_sched_barrier(0)
__device__ __forceinline__ void cmask(f32x16&p0,f32x16&p1,int jb,int qrel,int hi){
  const float NEG=-INFINITY; int kb=64*jb+4*hi;
  #pragma unroll
  for(int r=0;r<16;++r){int kv=kb+(r&3)+8*(r>>2); if(kv>qrel)p0[r]=NEG; if(kv+32>qrel)p1[r]=NEG;}
}

constexpr int NSLOT=3, SLOTB=8192;
constexpr int LDS_K=0, LDS_V=NSLOT*SLOTB, LDS_WS=2*NSLOT*SLOTB, LDS_OST=LDS_WS+NW*64*4, LDS_BYTES=LDS_OST+NW*4096;
constexpr float C2=0.125f*1.4426950408889634f;
__device__ __forceinline__ void glds16(const void*gsrc,unsigned lds_dst){unsigned keep;
  asm volatile("s_mov_b32 %0, m0\n\ts_mov_b32 m0, %2\n\ts_nop 0\n\tglobal_load_lds_dwordx4 %1, off\n\ts_mov_b32 m0, %0":"=&s"(keep):"v"(gsrc),"s"(lds_dst):"memory");}
__device__ __forceinline__ float max3f(float a,float b,float c){float r;asm("v_max3_f32 %0, %1, %2, %3":"=v"(r):"v"(a),"v"(b),"v"(c));return r;}
__device__ __forceinline__ float max2f(float a,float b){float r;asm("v_max_f32_e32 %0, %1, %2":"=v"(r):"v"(a),"v"(b));return r;}
__device__ __forceinline__ float fadd_s(float a,float b){float r;asm("v_add_f32_e32 %0, %1, %2":"=v"(r):"v"(a),"v"(b));return r;}
__device__ __forceinline__ float fsub_s(float a,float b){float r;asm("v_sub_f32_e32 %0, %1, %2":"=v"(r):"v"(a),"v"(b));return r;}
typedef float f32x2_t __attribute__((ext_vector_type(2))); typedef __bf16 bf16x2_t __attribute__((ext_vector_type(2)));
__device__ __forceinline__ unsigned cvtpk_s(float lo,float hi){f32x2_t v={lo,hi};bf16x2_t b=__builtin_convertvector(v,bf16x2_t);return __builtin_bit_cast(unsigned,b);}
#define WAIT_BAR(N) asm volatile("s_waitcnt vmcnt(" #N ") lgkmcnt(0)\n\ts_barrier":::"memory")

__device__ __forceinline__ void qkt(f32x16&p0,f32x16&p1,const char*Kslot,const bf16x8*qr,const f32x16&negm,int r32,int hi){
  const char*kb=Kslot+hi*1024+r32*16;
  #pragma unroll
  for(int d0=0;d0<4;++d0){
    const bf16x8 b0=*reinterpret_cast<const bf16x8*>(kb+d0*2048);
    const bf16x8 b1=*reinterpret_cast<const bf16x8*>(kb+d0*2048+512);
    if(d0==0){p0=__builtin_amdgcn_mfma_f32_32x32x16_bf16(b0,qr[0],negm,0,0,0);p1=__builtin_amdgcn_mfma_f32_32x32x16_bf16(b1,qr[0],negm,0,0,0);}
    else{p0=__builtin_amdgcn_mfma_f32_32x32x16_bf16(b0,qr[d0],p0,0,0,0);p1=__builtin_amdgcn_mfma_f32_32x32x16_bf16(b1,qr[d0],p1,0,0,0);}}
}
typedef __attribute__((address_space(3))) const char* lds_cptr;
typedef short v4i16_t __attribute__((ext_vector_type(4)));
__device__ __forceinline__ void kload8(bf16x8*kf,lds_cptr kp){
  kf[0]=*(const __attribute__((address_space(3))) bf16x8*)(kp);      kf[1]=*(const __attribute__((address_space(3))) bf16x8*)(kp+512);
  kf[2]=*(const __attribute__((address_space(3))) bf16x8*)(kp+2048); kf[3]=*(const __attribute__((address_space(3))) bf16x8*)(kp+2560);
  kf[4]=*(const __attribute__((address_space(3))) bf16x8*)(kp+4096); kf[5]=*(const __attribute__((address_space(3))) bf16x8*)(kp+4608);
  kf[6]=*(const __attribute__((address_space(3))) bf16x8*)(kp+6144); kf[7]=*(const __attribute__((address_space(3))) bf16x8*)(kp+6656);
}
__device__ __forceinline__ void kload2(bf16x8*kf,lds_cptr kp,int j){ kf[2*j]=*(const __attribute__((address_space(3))) bf16x8*)(kp+j*2048); kf[2*j+1]=*(const __attribute__((address_space(3))) bf16x8*)(kp+j*2048+512); }
__device__ __forceinline__ s16x4 vtr(lds_cptr p){ return __builtin_bit_cast(s16x4,__builtin_amdgcn_ds_read_tr16_b64_v4i16((__attribute__((address_space(3))) v4i16_t*)p)); }
__device__ __forceinline__ float rowmax(const f32x16&p0,const f32x16&p1){
  float a=max3f(p0[0],p0[1],p1[0]),b=max3f(p0[2],p0[3],p1[1]);a=max3f(a,p1[2],p1[3]);
  #pragma unroll
  for(int r=4;r<16;r+=4){a=max3f(a,p0[r],p0[r+1]);b=max3f(b,p0[r+2],p0[r+3]);a=max3f(a,p1[r],p1[r+1]);b=max3f(b,p1[r+2],p1[r+3]);}
  const float m=max2f(a,b);
  auto rr=__builtin_amdgcn_permlane32_swap(__float_as_uint(m),__float_as_uint(m),false,false);
  return max2f(__uint_as_float(rr[0]),__uint_as_float(rr[1]));
}
__device__ __forceinline__ void pv(f32x16*o,int vb,bf16x8 pa0,bf16x8 pa1,bf16x8 pa2,bf16x8 pa3){
  #pragma unroll
  for(int d0=0;d0<2;++d0){s16x4 lo[4],hi[4];
    #pragma unroll
    for(int ks=0;ks<4;++ks){
      asm volatile("ds_read_b64_tr_b16 %0,%1 offset:%c2":"=&v"(lo[ks]):"v"(vb),"i"(d0*4096+ks*1024):"memory");
      asm volatile("ds_read_b64_tr_b16 %0,%1 offset:%c2":"=&v"(hi[ks]):"v"(vb),"i"(d0*4096+ks*1024+512):"memory");}
    asm volatile("s_waitcnt lgkmcnt(0)":::"memory");SBAR();
    #define PK(k) (bf16x8){lo[k][0],lo[k][1],lo[k][2],lo[k][3],hi[k][0],hi[k][1],hi[k][2],hi[k][3]}
    o[d0]=__builtin_amdgcn_mfma_f32_32x32x16_bf16(pa0,PK(0),o[d0],0,0,0);
    o[d0]=__builtin_amdgcn_mfma_f32_32x32x16_bf16(pa1,PK(1),o[d0],0,0,0);
    o[d0]=__builtin_amdgcn_mfma_f32_32x32x16_bf16(pa2,PK(2),o[d0],0,0,0);
    o[d0]=__builtin_amdgcn_mfma_f32_32x32x16_bf16(pa3,PK(3),o[d0],0,0,0);
    #undef PK
  }
}

#ifndef ATTN_STORE16
#define ATTN_STORE16(p,v) (*(u32x4*)(p)=(v))
#endif
template<int THRL> __device__ __forceinline__ void attn_unit(int b,int h,int qb,const bf16*Q,const bf16*__restrict__ K,const bf16*__restrict__ V,bf16*O,char*shm){
  int tid_=threadIdx.x; asm volatile("":"+v"(tid_)); const int tid=tid_,lane=tid&63,r32=lane&31,hi=lane>>5; const int wid=__builtin_amdgcn_readfirstlane(tid>>6);
  const long rowbase=(long)b*SEQ; const int q0=qb*QB;
  const bf16*Qw=Q+(rowbase+q0+wid*QBLK)*QP+h*D;
  const bf16*Kh=K+rowbase*KP+(h>>1)*D,*Vh=V+rowbase*VP+(h>>1)*D;
  const unsigned lds0=(unsigned)(uintptr_t)shm;
  float*wsf=(float*)(shm+LDS_WS)+wid*64;
  const bf16*ksrc=Kh+(long)lane*KP+wid*8;
  const bf16*vsrc=Vh+(long)(16*(wid&3)+(lane>>2))*VP+(wid>>2)*32+(lane&3)*8;
  const unsigned kdst=lds0+LDS_K+wid*1024, vdst=lds0+LDS_V+wid*1024;
  #define DMA_K(t,slot) glds16(ksrc+(long)(t)*KVBLK*KP,(unsigned)__builtin_amdgcn_readfirstlane(kdst+(slot)))
  #define DMA_V(t,slot) glds16(vsrc+(long)(t)*KVBLK*VP,(unsigned)__builtin_amdgcn_readfirstlane(vdst+(slot)))
  const int vb0=(int)(lds0+LDS_V)+((lane>>4)&1)*32+(lane&3)*8+(4*hi+((lane&15)>>2))*64;
  const char*Kbase=shm+LDS_K; bf16x8 kf[8];
  const lds_cptr shm3=(lds_cptr)shm; const lds_cptr kp0=shm3+LDS_K+hi*1024+r32*16; const lds_cptr vp0=shm3+LDS_V+((lane>>4)&1)*32+(lane&3)*8+(4*hi+((lane&15)>>2))*64;
  const int NT=SEQ/KVBLK;
  DMA_K(0,0);DMA_V(0,0);DMA_K(1,SLOTB);
  bf16x8 qr[4];
  #pragma unroll
  for(int d0=0;d0<4;++d0)qr[d0]=*reinterpret_cast<const bf16x8*>(&Qw[(long)r32*QP+d0*16+hi*8]);
  float mhat=0.f,l_reg=0.f;f32x16 o[2];o[0]=f32x16{};o[1]=f32x16{};f32x16 negm=f32x16{};asm volatile("":"+v"(negm));
  #define CMASK(P0,P1,t) do{}while(0)
  bool resc=false;
  #define START(P0,P1) do{ const float rm=rowmax(P0,P1); resc=false; \
    { const float dl=rm; mhat=fadd_s(mhat,dl); \
      _Pragma("unroll") for(int r=0;r<16;++r){P0[r]=fsub_s(P0[r],dl);P1[r]=fsub_s(P1[r],dl);} \
      _Pragma("unroll") for(int r=0;r<16;++r)negm[r]=-mhat; asm volatile("":"+v"(negm)); } \
    _Pragma("unroll") for(int r=0;r<16;++r)P0[r]=__builtin_amdgcn_exp2f(P0[r]); }while(0)
  #define RESC() do{ if(resc){ asm volatile("s_waitcnt lgkmcnt(0)":::"memory"); \
      _Pragma("unroll") for(int d_=0;d_<2;++d_) _Pragma("unroll") for(int r=0;r<16;++r)o[d_][r]*=wsf[crow(r,hi)]; } }while(0)
  f32x16 pA0,pA1,pB0,pB1;
  int sl_prev=0,sl_cur=0,sl_next=SLOTB;
  #define ROT() do{sl_prev=sl_cur;sl_cur=sl_next;sl_next=(sl_next==(NSLOT-1)*SLOTB)?0:sl_next+SLOTB;}while(0)
  DMA_K(2,2*SLOTB);
  WAIT_BAR(3);
  qkt(pA0,pA1,Kbase,qr,negm,r32,hi);asm volatile("s_nop 15\n\ts_nop 7":"+v"(pA0),"+v"(pA1));CMASK(pA0,pA1,0);
  START(pA0,pA1);
  _Pragma("unroll") for(int r=0;r<16;++r)pA1[r]=__builtin_amdgcn_exp2f(pA1[r]);
  WAIT_BAR(0);
  DMA_K(3,0);DMA_V(1,SLOTB);
  ROT();
  kload8(kf,kp0+sl_cur);
  WAIT_BAR(2);
  s16x4 vlo[8],vhi[8]; u32x4 pw0,pw1,pw2,pw3;
  #define PKW(P,B) cvtpk_s(P[B],P[B+1])
  #define PAF(k) __builtin_bit_cast(bf16x8,pw##k)
  #define VFR(i) (bf16x8){vlo[i][0],vlo[i][1],vlo[i][2],vlo[i][3],vhi[i][0],vhi[i][1],vhi[i][2],vhi[i][3]}
  #define PIN(x) asm volatile("":"+v"(x))
  #define MX3(a,b,c) __builtin_fmaxf(__builtin_fmaxf((a),(b)),(c))
  #define GAPA(MF,A0,A1,A2,A3,W0,W1,PW) do{ MF; sacc+=A0; sacc+=A1; sacc+=A2; sacc+=A3; PIN(sacc); W0; W1; PIN(PW); SBAR(); }while(0)
  #define EX(v) __builtin_amdgcn_exp2f(v)
  #define GAPB(MF,X,B) do{ MF; X[B]=EX(X[B]); X[B+1]=EX(X[B+1]); X[B+2]=EX(X[B+2]); X[B+3]=EX(X[B+3]); PIN(X); SBAR(); }while(0)
  #define VRD(i) do{ vlo[i]=vtr(vp_+(((i)>>2)*4096+((i)&3)*1024)); vhi[i]=vtr(vp_+(((i)>>2)*4096+((i)&3)*1024+512)); }while(0)
  #define KRD(G,j) do{ if(G){ kload2(kf,kp0+sl_next,j); SBAR(); } }while(0)
  #define STEP(C0,C1,P0,P1,t,GK,GV,GL) do{ SBAR(); \
    const lds_cptr vp_=vp0+sl_prev; \
    VRD(0); SBAR(); float sacc=(P0[0]+P0[1]); \
    GAPA(C0=__builtin_amdgcn_mfma_f32_32x32x16_bf16(kf[0],qr[0],negm,0,0,0), P0[2],P0[3],P0[4],P0[5],     pw0[0]=PKW(P0,0), pw0[1]=PKW(P0,2), pw0); \
    VRD(4); SBAR(); GAPA(C1=__builtin_amdgcn_mfma_f32_32x32x16_bf16(kf[1],qr[0],negm,0,0,0), P0[6],P0[7],P0[8],P0[9],     pw0[2]=PKW(P0,4), pw0[3]=PKW(P0,6), pw0); \
    VRD(1); SBAR(); GAPA(C0=__builtin_amdgcn_mfma_f32_32x32x16_bf16(kf[2],qr[1],C0,0,0,0),   P0[10],P0[11],P0[12],P0[13], pw1[0]=PKW(P0,8), pw1[1]=PKW(P0,10), pw1); \
    VRD(5); SBAR(); GAPA(C1=__builtin_amdgcn_mfma_f32_32x32x16_bf16(kf[3],qr[1],C1,0,0,0),   P0[14],P0[15],P1[0],P1[1],   pw1[2]=PKW(P0,12),pw1[3]=PKW(P0,14), pw1); \
    VRD(2); SBAR(); GAPA(C0=__builtin_amdgcn_mfma_f32_32x32x16_bf16(kf[4],qr[2],C0,0,0,0),   P1[2],P1[3],P1[4],P1[5],     pw2[0]=PKW(P1,0), pw2[1]=PKW(P1,2), pw2); \
    VRD(6); SBAR(); GAPA(C1=__builtin_amdgcn_mfma_f32_32x32x16_bf16(kf[5],qr[2],C1,0,0,0),   P1[6],P1[7],P1[8],P1[9],     pw2[2]=PKW(P1,4), pw2[3]=PKW(P1,6), pw2); \
    VRD(3); SBAR(); GAPA(C0=__builtin_amdgcn_mfma_f32_32x32x16_bf16(kf[6],qr[3],C0,0,0,0),   P1[10],P1[11],P1[12],P1[13], pw3[0]=PKW(P1,8), pw3[1]=PKW(P1,10), pw3); \
    VRD(7); SBAR(); GAPA(C1=__builtin_amdgcn_mfma_f32_32x32x16_bf16(kf[7],qr[3],C1,0,0,0),   P1[14],P1[15],0.f,0.f,       pw3[2]=PKW(P1,12),pw3[3]=PKW(P1,14), pw3); \
    l_reg+=sacc; \
    if(GK){DMA_K((t)+3,sl_cur);} if(GV){DMA_V((t)+1,sl_next);} \
    CMASK(C0,C1,t); \
    { float a=MX3(C0[0],C0[1],C1[0]),b=MX3(C0[2],C0[3],C1[1]); a=MX3(a,C1[2],C1[3]); \
      _Pragma("unroll") for(int r=4;r<16;r+=4){a=MX3(a,C0[r],C0[r+1]);b=MX3(b,C0[r+2],C0[r+3]);a=MX3(a,C1[r],C1[r+1]);b=MX3(b,C1[r+2],C1[r+3]);} \
      float rm=__builtin_fmaxf(a,b); { auto rr=__builtin_amdgcn_permlane32_swap(__float_as_uint(rm),__float_as_uint(rm),false,false); rm=__builtin_fmaxf(__uint_as_float(rr[0]),__uint_as_float(rr[1])); } \
      resc=false; \
      if(__builtin_expect(__any(rm>(float)THRL),0)){ const float dl=__builtin_fmaxf(rm,0.f); mhat+=dl; \
        _Pragma("unroll") for(int r=0;r<16;++r){C0[r]-=dl;C1[r]-=dl;} \
        _Pragma("unroll") for(int r=0;r<16;++r)negm[r]=-mhat; asm volatile("":"+v"(negm)); \
        const float f=__builtin_amdgcn_exp2f(-dl); l_reg*=f; if(hi==0)wsf[r32]=f; resc=true; } } \
    SBAR(); \
    GAPB(o[0]=__builtin_amdgcn_mfma_f32_32x32x16_bf16(PAF(0),VFR(0),o[0],0,0,0), C0,0); \
    GAPB(o[1]=__builtin_amdgcn_mfma_f32_32x32x16_bf16(PAF(0),VFR(4),o[1],0,0,0), C0,4); \
    KRD(GL,0); GAPB(o[0]=__builtin_amdgcn_mfma_f32_32x32x16_bf16(PAF(1),VFR(1),o[0],0,0,0), C0,8); \
    KRD(GL,1); GAPB(o[1]=__builtin_amdgcn_mfma_f32_32x32x16_bf16(PAF(1),VFR(5),o[1],0,0,0), C0,12); \
    KRD(GL,2); GAPB(o[0]=__builtin_amdgcn_mfma_f32_32x32x16_bf16(PAF(2),VFR(2),o[0],0,0,0), C1,0); \
    KRD(GL,3); GAPB(o[1]=__builtin_amdgcn_mfma_f32_32x32x16_bf16(PAF(2),VFR(6),o[1],0,0,0), C1,4); \
    GAPB(o[0]=__builtin_amdgcn_mfma_f32_32x32x16_bf16(PAF(3),VFR(3),o[0],0,0,0), C1,8); \
    GAPB(o[1]=__builtin_amdgcn_mfma_f32_32x32x16_bf16(PAF(3),VFR(7),o[1],0,0,0), C1,12); \
    }while(0)
  int t=1;
  #undef CMASK
  #define CMASK(P0,P1,t) do{}while(0)
  for(;t+5<NT;t+=2){
    STEP(pB0,pB1,pA0,pA1,t,true,true,true);     WAIT_BAR(2); RESC(); ROT();
    STEP(pA0,pA1,pB0,pB1,t+1,true,true,true);   WAIT_BAR(2); RESC(); ROT();
  }
  #undef CMASK
  #define CMASK(P0,P1,t) do{}while(0)
  #define ENDW(tt) do{ if((tt)+3<NT){WAIT_BAR(2);} else if((tt)+2<NT){WAIT_BAR(1);} else {WAIT_BAR(0);} }while(0)
  for(;t+1<NT;t+=2){
    STEP(pB0,pB1,pA0,pA1,t,(t+3<NT),(t+1<NT),(t+1<NT));       ENDW(t);   RESC(); ROT();
    STEP(pA0,pA1,pB0,pB1,t+1,(t+4<NT),(t+2<NT),(t+2<NT));     ENDW(t+1); RESC(); ROT();
  }
  STEP(pB0,pB1,pA0,pA1,NT-1,false,false,false); RESC();
  { float sacc=pB0[0]+pB0[1]; _Pragma("unroll") for(int r=2;r<16;++r)sacc+=pB0[r]; _Pragma("unroll") for(int r=0;r<16;++r)sacc+=pB1[r]; l_reg+=sacc;
    pw0=(u32x4){PKW(pB0,0),PKW(pB0,2),PKW(pB0,4),PKW(pB0,6)};pw1=(u32x4){PKW(pB0,8),PKW(pB0,10),PKW(pB0,12),PKW(pB0,14)};pw2=(u32x4){PKW(pB1,0),PKW(pB1,2),PKW(pB1,4),PKW(pB1,6)};pw3=(u32x4){PKW(pB1,8),PKW(pB1,10),PKW(pB1,12),PKW(pB1,14)};
    SBAR(); pv(o,vb0+sl_cur,PAF(0),PAF(1),PAF(2),PAF(3)); }
  #undef PKW
  #undef PAF
  #undef VFR
  #undef PIN
  #undef MX3
  #undef GAPA
  #undef GAPB
  #undef EX
  #undef VRD
  #undef KRD
  #undef STEP
  #undef ENDW
  {auto rr=__builtin_amdgcn_permlane32_swap(__float_as_uint(l_reg),__float_as_uint(l_reg),false,false);l_reg=__uint_as_float(rr[0])+__uint_as_float(rr[1]);}
  if(hi==0)wsf[32+r32]=l_reg;asm volatile("s_waitcnt lgkmcnt(0)":::"memory");
  float rli[16];
  #pragma unroll
  for(int r=0;r<16;++r)rli[r]=__builtin_amdgcn_rcpf(wsf[32+crow(r,hi)]);
  bf16*Ow=O+(rowbase+q0+wid*QBLK)*OP+h*D;
  { bf16*stg=(bf16*)(shm+LDS_OST)+wid*2048;
    #pragma unroll
    for(int r=0;r<16;++r){const int orow=crow(r,hi);
      #pragma unroll
      for(int d0=0;d0<2;++d0)stg[orow*64+d0*32+r32]=__float2bfloat16(o[d0][r]*rli[r]);}
    asm volatile("s_waitcnt lgkmcnt(0)":::"memory");
    #pragma unroll
    for(int i=0;i<4;++i){const int row=i*8+(lane>>3),ch=lane&7; const u32x4 v=*(const u32x4*)(stg+row*64+ch*8); ATTN_STORE16(Ow+(long)row*OP+ch*8,v);} }
  asm volatile("s_waitcnt lgkmcnt(0)\n\ts_barrier":::"memory");
  #undef DMA_K
  #undef DMA_V
  #undef CMASK
  #undef START
  #undef RESC
  #undef ROT
}
constexpr int ATTN_LDS_BYTES=LDS_BYTES;
struct AttnTensors { const bf16* Q; const bf16* K; const bf16* V; bf16* O; };
struct AttnUnit { int b; int h; int qb; };
struct StaticOrder {
  int vcu;
  __device__ __forceinline__ explicit StaticOrder(int vcu_):vcu(vcu_){}
  __device__ __forceinline__ bool next(int i,AttnUnit&u)const{ if(i>=4)return false; const int x=vcu>>5,j=vcu&31,grp=2*x+(i>>1); u.b=grp>>1; u.h=(grp&1)*2+(i&1); u.qb=j; return true; }
  __device__ __forceinline__ void a_ready(const AttnUnit&)const{}
  __device__ __forceinline__ void done(const AttnUnit&)const{}
};
template<class Sched,int THRL=8> __device__ __forceinline__ void attn_phase(char*lds,const AttnTensors&T,const Sched&S){
  AttnUnit u;
  for(int i=0;S.next(i,u);++i){ S.a_ready(u); attn_unit<THRL>(u.b,u.h,u.qb,T.Q,T.K,T.V,T.O,lds); S.done(u); }
}
#undef SBAR
#undef WAIT_BAR
}

#define GAS __attribute__((address_space(1)))
#define LAS __attribute__((address_space(3)))
typedef unsigned short bf16;
typedef unsigned v4u __attribute__((ext_vector_type(4)));
typedef float f32x4 __attribute__((ext_vector_type(4)));
typedef short bf16x8 __attribute__((ext_vector_type(8)));
typedef GAS unsigned gu32;
typedef GAS unsigned long long gu64;
#define RLX_AGENT __ATOMIC_RELAXED, __HIP_MEMORY_SCOPE_AGENT
#define LDS_WAIT() asm volatile("s_waitcnt lgkmcnt(0)" ::: "memory")
#define VM_WAIT() asm volatile("s_waitcnt vmcnt(0)" ::: "memory")
__device__ __forceinline__ unsigned long long rt() { return __builtin_amdgcn_s_memrealtime(); }
__device__ __forceinline__ unsigned f2bf(float f) { unsigned u = __builtin_bit_cast(unsigned, f); return (u + 0x7fffu + ((u >> 16) & 1u)) >> 16; }
__device__ __forceinline__ unsigned pk2(float lo, float hi) { return f2bf(lo) | (f2bf(hi) << 16); }

#define XB_TMO      128
#define XB_XCNT(j)  (256  + 64 * (j))
#define XB_XSUB(j)  (1280 + 64 * (j))
#define XB_XGEN(j)  (2304 + 64 * (j))
#define XB_TOP      3328
#define XB_TOPGEN   3392
#define XCD_BAR_WORDS 3456
#define XB_SPIN_CAP (1u << 18)

__device__ __forceinline__ unsigned xb_ld(unsigned* p)              { return __hip_atomic_load(p, __ATOMIC_RELAXED, __HIP_MEMORY_SCOPE_AGENT); }
__device__ __forceinline__ unsigned xb_add(unsigned* p, unsigned v) { return __hip_atomic_fetch_add(p, v, __ATOMIC_RELAXED, __HIP_MEMORY_SCOPE_AGENT); }
__device__ __forceinline__ unsigned xb_xcc_id() { return (unsigned)__builtin_amdgcn_s_getreg((3 << 11) | 20) & 0xFu; }
#define XB_SPIN(cond, bar) do { unsigned _sp = 0; while (cond) { __builtin_amdgcn_s_sleep(1); \
    if ((++_sp & 255u) == 0u) { if (xb_ld(&(bar)[XB_TMO])) break; if (_sp > XB_SPIN_CAP) { atomicAdd(&(bar)[XB_TMO], 1u); break; } } } } while (0)

struct XcdBarrier {
    unsigned* bar; unsigned x;
    volatile LAS unsigned* st;
};

__device__ __forceinline__ XcdBarrier xcd_barrier_post(unsigned* bar, volatile LAS unsigned* st) {
    XcdBarrier b; b.bar = bar; b.x = xb_xcc_id(); b.st = st;
    if (threadIdx.x == 0) (void)xb_add(&bar[XB_XCNT(b.x)], 1u);
    return b;
}
__device__ __forceinline__ void xcd_barrier_complete(unsigned* bar, unsigned x, unsigned& nloc, unsigned& nx) {
    const unsigned G = gridDim.x * gridDim.y * gridDim.z;
    unsigned sum, cnt, mine, sp = 0u;
    for (;;) {
        sum = 0u; cnt = 0u; mine = 0u;
#pragma unroll
        for (unsigned j = 0; j < 16; ++j) { const unsigned c = xb_ld(&bar[XB_XCNT(j)]); sum += c; cnt += (c > 0u) ? 1u : 0u; mine = (j == x) ? c : mine; }
        if (sum == G) break;
        __builtin_amdgcn_s_sleep(1);
        if ((++sp & 255u) == 0u) { if (xb_ld(&bar[XB_TMO])) break; if (sp > XB_SPIN_CAP) { atomicAdd(&bar[XB_TMO], 1u); break; } }
    }
    nloc = mine > 0u ? mine : 1u; nx = cnt > 0u ? cnt : 1u;
}

__device__ __forceinline__ void xcd_barrier(const XcdBarrier& b) {
    asm volatile("s_waitcnt vmcnt(0)" ::: "memory");
    __syncthreads();
    if (threadIdx.x == 0) {
        unsigned* bar = b.bar;
        __builtin_amdgcn_s_waitcnt(0);
        unsigned nloc = b.st[0], nx = b.st[1];
        if (nloc == 0u) { xcd_barrier_complete(bar, b.x, nloc, nx); b.st[0] = nloc; b.st[1] = nx; }
        const unsigned old = xb_add(&bar[XB_XSUB(b.x)], 1u);
        const unsigned gen = old / nloc;
        if (old + 1u == (gen + 1u) * nloc) {
            __builtin_amdgcn_fence(__ATOMIC_RELEASE, "agent");
            asm volatile("s_waitcnt vmcnt(0)" ::: "memory");
            const unsigned og = xb_add(&bar[XB_TOP], 1u);
            const unsigned tg = og / nx;
            if (og + 1u == (tg + 1u) * nx) xb_add(&bar[XB_TOPGEN], 1u);
            else XB_SPIN(xb_ld(&bar[XB_TOPGEN]) == tg, bar);
            __builtin_amdgcn_fence(__ATOMIC_ACQUIRE, "agent");
            xb_add(&bar[XB_XGEN(b.x)], 1u);
            asm volatile("s_waitcnt vmcnt(0)" ::: "memory");
        } else {
            XB_SPIN(xb_ld(&bar[XB_XGEN(b.x)]) == gen, bar);
            __builtin_amdgcn_fence(__ATOMIC_ACQUIRE, "agent");
            asm volatile("s_waitcnt vmcnt(0)" ::: "memory");
        }
    }
    __syncthreads();
}


namespace pg8 {
__device__ __forceinline__ float bflo(unsigned w) { return __uint_as_float(w << 16); }
__device__ __forceinline__ float bfhi(unsigned w) { return __uint_as_float(w & 0xffff0000u); }
__device__ __forceinline__ float sigm(float z) { return __builtin_amdgcn_rcpf(1.0f + __builtin_amdgcn_exp2f(-1.4426950408889634f * z)); }
typedef unsigned u32x2 __attribute__((ext_vector_type(2)));

struct BranchOrder : StaticOrder {
    __device__ bool next(int i, Unit& u) const { if (!StaticOrder::next(i, u)) return false; u.ka = (u.pn >> 2) * 256; return true; }
};
struct EpiGate {
    static constexpr bool PERM = false, AFTER_DRAIN = false;
    const bf16_t* P; const float* bg; bf16_t* O;
    __device__ __forceinline__ void operator()(const f32x4 (&acc)[2][2][4][2], const Unit& u, int wr, int wc, int fr, int fq) const {
        const int d0 = u.pn * 64 + 16 * wc + 4 * fq;
        f32x4 bv[2][2];
#pragma unroll
        for (int bj = 0; bj < 2; ++bj)
#pragma unroll
            for (int n = 0; n < 2; ++n) bv[bj][n] = *(const f32x4*)(bg + (2 * bj + n) * 1024 + d0);
#pragma unroll
        for (int ai = 0; ai < 2; ++ai)
#pragma unroll
            for (int m = 0; m < 4; ++m) { const size_t row = (size_t)(u.pm * BM + ai * HALF + wr * 64 + m * 16 + fr); const bf16_t* prow = P + row * 4096 + d0;
                f32x4 s = (f32x4){0.f, 0.f, 0.f, 0.f};
#pragma unroll
                for (int bj = 0; bj < 2; ++bj)
#pragma unroll
                    for (int n = 0; n < 2; ++n) { const u32x2 pw = *(const u32x2*)(prow + (2 * bj + n) * 1024); const f32x4 z = acc[ai][bj][m][n] + bv[bj][n];
                        s[0] += sigm(z[0]) * bflo(pw.x); s[1] += sigm(z[1]) * bfhi(pw.x); s[2] += sigm(z[2]) * bflo(pw.y); s[3] += sigm(z[3]) * bfhi(pw.y); }
                u32x2 w; w.x = cvt_pk_bf16(s[0], s[1]); w.y = cvt_pk_bf16(s[2], s[3]); *(u32x2*)(O + row * 1024 + d0) = w; }
    }
};
struct EpiResid {
    static constexpr bool PERM = false, AFTER_DRAIN = false;
    float* H; float alpha;
    __device__ __forceinline__ void operator()(const f32x4 (&acc)[2][2][4][2], const Unit& u, int wr, int wc, int fr, int fq) const {
        const int row0 = u.pm * BM + wr * 64 + fr, col0 = u.pn * BM + wc * 32 + 4 * fq;
#pragma unroll
        for (int ai = 0; ai < 2; ++ai)
#pragma unroll
            for (int m = 0; m < 4; ++m) { float* rowp = H + (size_t)(row0 + ai * HALF + m * 16) * 1024 + col0;
#pragma unroll
                for (int bj = 0; bj < 2; ++bj)
#pragma unroll
                    for (int n = 0; n < 2; ++n) { f32x4* p = (f32x4*)(rowp + bj * HALF + n * 16); const f32x4 h = *p; *p = h * alpha + acc[ai][bj][m][n]; } }
    }
};
struct EpiSwiglu {
    static constexpr bool PERM = true, AFTER_DRAIN = false;
    bf16_t* O; const float* bgu;
    __device__ __forceinline__ void operator()(const f32x4 (&acc)[2][2][4][2], const Unit& u, int wr, int wc, int fr, int fq) const {
        const int e = u.pn >> 3, ct = u.pn & 7, cc0 = ct * 128 + wc * 32 + 8 * fq;
        const float* bb = bgu + e * 2048 + cc0;
        f32x4 bg[2], bl[2];
#pragma unroll
        for (int n = 0; n < 2; ++n) { bg[n] = *(const f32x4*)(bb + 4 * n); bl[n] = *(const f32x4*)(bb + 1024 + 4 * n); }
#pragma unroll
        for (int ai = 0; ai < 2; ++ai)
#pragma unroll
            for (int m = 0; m < 4; ++m) { const size_t row = (size_t)(u.pm * BM + ai * HALF + wr * 64 + m * 16 + fr);
                float o[8];
#pragma unroll
                for (int n = 0; n < 2; ++n)
#pragma unroll
                    for (int j = 0; j < 4; ++j) { float gl = acc[ai][0][m][n][j] + bg[n][j], li = acc[ai][1][m][n][j] + bl[n][j];
                        gl = fminf(gl, 7.0f); li = fminf(fmaxf(li, -7.0f), 7.0f); o[4 * n + j] = gl * sigm(1.702f * gl) * (li + 1.0f); }
                u32x4 w; w.x = cvt_pk_bf16(o[0], o[1]); w.y = cvt_pk_bf16(o[2], o[3]); w.z = cvt_pk_bf16(o[4], o[5]); w.w = cvt_pk_bf16(o[6], o[7]);
                *(u32x4*)(O + row * 1024 + cc0) = w; }
    }
};
struct EpiDown {
    static constexpr bool PERM = true, AFTER_DRAIN = false;
    bf16_t* O; const float* bd;
    __device__ __forceinline__ void operator()(const f32x4 (&acc)[2][2][4][2], const Unit& u, int wr, int wc, int fr, int fq) const {
        const int e = u.pn >> 2, ct = u.pn & 3, col0 = ct * 256 + wc * 32 + 8 * fq;
        const float* bb = bd + e * 1024 + col0;
        f32x4 bv[2][2];
#pragma unroll
        for (int bj = 0; bj < 2; ++bj)
#pragma unroll
            for (int n = 0; n < 2; ++n) bv[bj][n] = *(const f32x4*)(bb + bj * HALF + 4 * n);
#pragma unroll
        for (int ai = 0; ai < 2; ++ai)
#pragma unroll
            for (int m = 0; m < 4; ++m) { bf16_t* rowp = O + (size_t)(u.pm * BM + ai * HALF + wr * 64 + m * 16 + fr) * 1024 + col0;
#pragma unroll
                for (int bj = 0; bj < 2; ++bj) { const f32x4 v0 = acc[ai][bj][m][0] + bv[bj][0], v1 = acc[ai][bj][m][1] + bv[bj][1];
                    u32x4 w; w.x = cvt_pk_bf16(v0[0], v0[1]); w.y = cvt_pk_bf16(v0[2], v0[3]); w.z = cvt_pk_bf16(v1[0], v1[1]); w.w = cvt_pk_bf16(v1[2], v1[3]);
                    *(u32x4*)(rowp + bj * HALF) = w; } }
    }
};
struct MoeOrder {
    const PG8_LAS int* tab; int nct, G, c;
    __device__ bool next(int i, Unit& u) const {
        const int L = i * G + c; if (L >= tab[32]) return false;
        int e = 0;
#pragma unroll 1
        while (e < 31 && L >= tab[e + 1]) ++e;
        const int r = L - tab[e], nt = (tab[e + 1] - tab[e]) / nct, nig = 8 * nct, gid = r / nig, fm = gid * 8, gsz = (nt - fm) < 8 ? (nt - fm) : 8, rr = r % nig;
        u.pm = tab[33 + e] + fm + (rr % gsz); u.pn = e * nct + rr / gsz; u.ka = 0; return true;
    }
    __device__ __forceinline__ void a_ready(const Unit&) const {}
    __device__ __forceinline__ void done(const Unit&) const {}
};
}

constexpr int NWAVES = 8;
#ifndef MK_ONE_LAUNCH
#define MK_ONE_LAUNCH 1
#endif
constexpr int NB = 8, SEQ = 8192, D = 1024, M = NB * SEQ, DEPTH = 2;
constexpr int IN_COLS = 6144, ZSW = 2048;
constexpr int NE = 32, TOPK = 4, RMAX = M * TOPK + NE * 256;
constexpr float DN_ALPHA = 1.4142135623730951f, LN_EPS = 1e-5f, RMS_EPS = 1e-6f;
constexpr float QSCALE = 0.125f * 1.4426950408889634f;
constexpr int NSUB = 11, NPH = 1 + DEPTH * NSUB;
constexpr size_t MiB = 1u << 20;
constexpr size_t WS_CTL = 0, CTL_ZERO_BYTES = 1 * MiB;
constexpr size_t WS_TOPE = 1 * MiB, WS_TOPW = 2 * MiB, WS_TOPR = 3 * MiB, WS_WGB = 4 * MiB, WS_ROPE = 5 * MiB;
constexpr size_t WS_W0 = 8 * MiB, W_LAYER = 208 * MiB;
constexpr size_t WO_INS = 0, WO_G = 4 * MiB, WO_B = 12 * MiB, WO_O = 14 * MiB, WO_GU = 16 * MiB, WO_D = 144 * MiB;
constexpr size_t WS_HB = WS_W0 + 2 * W_LAYER;
constexpr size_t WS_OV = WS_HB + 128 * MiB;
constexpr size_t WS_ZS = WS_OV, WS_QN = WS_OV + 256 * MiB, WS_KN = WS_OV + 288 * MiB, WS_BR = WS_OV + 304 * MiB, WS_MG = WS_OV + 432 * MiB, WS_P = WS_OV + 560 * MiB;
constexpr size_t WS_XS = WS_OV, WS_Y = WS_OV, WS_HA = WS_OV + 528 * MiB;
constexpr size_t WS_END = WS_OV + 1072 * MiB;
static_assert((size_t)RMAX * 1024 * 2 <= 528 * MiB, "MoE row buffers");
constexpr int CW_TMO = 0, CW_CODE = 1, CW_BAR = 4096, CW_CNT = 8192;
constexpr int RING_OFF = 0, RING_BYTES = 131072;
constexpr int LDSCTL_OFF = RING_BYTES, MISC_OFF = LDSCTL_OFF + 320;
constexpr int TAB_OFF = LDSCTL_OFF + 1024;
constexpr int HIST_OFF = TAB_OFF + 512, LG_OFF = TAB_OFF + 1024;
constexpr int LDS_BYTES = 147456;

struct Args { const float* in[26]; float* out; unsigned char* ws; int ph_lo, ph_hi; };
typedef const __attribute__((address_space(4))) Args* CArgs;
struct Frame { LAS unsigned char* lds; volatile LAS unsigned* MISC; gu32* ctl; int tid, lane, wave, vcu, G, wg; };

using pg8::bflo; using pg8::bfhi; using pg8::sigm; using pg8::cvt_pk_bf16;
typedef unsigned v2u __attribute__((ext_vector_type(2)));
__device__ __forceinline__ float wave_sum(float v) {
#pragma unroll
    for (int o = 1; o < 64; o <<= 1) v += __shfl_xor(v, o);
    return v;
}
__device__ __forceinline__ void unpack8(const v4u v, float (&x)[8]) { x[0] = bflo(v.x); x[1] = bfhi(v.x); x[2] = bflo(v.y); x[3] = bfhi(v.y); x[4] = bflo(v.z); x[5] = bfhi(v.z); x[6] = bflo(v.w); x[7] = bfhi(v.w); }
__device__ __forceinline__ v4u pack8(const float (&x)[8]) { v4u o; o.x = cvt_pk_bf16(x[0], x[1]); o.y = cvt_pk_bf16(x[2], x[3]); o.z = cvt_pk_bf16(x[4], x[5]); o.w = cvt_pk_bf16(x[6], x[7]); return o; }

struct RmId { __device__ __forceinline__ int operator()(int n) const { return n; } };
struct RmGate { __device__ __forceinline__ int operator()(int n) const { const int g = n >> 10, d = n & 1023, pn = d >> 6, dl = d & 63; return 256 * pn + 128 * (g >> 1) + 32 * (dl >> 4) + 16 * (g & 1) + (dl & 15); } };
struct RmGlu { __device__ __forceinline__ int operator()(int n) const { const int j = n & 1023, lin = n >> 10; return 256 * (j >> 7) + 128 * lin + (j & 127); } };
template <class RM>
__device__ __forceinline__ void transpose_item(const float* W, int ldw, bf16* WT, int ldt, const RM rm, LAS float* scr, int kb, int nb, int lane) {
    const int k0 = 64 * kb, n0 = 32 * nb;
#pragma unroll 8
    for (int i = 0; i < 32; ++i) { const int kk = 2 * i + (lane >> 5); scr[kk * 33 + (lane & 31)] = W[(size_t)(k0 + kk) * ldw + n0 + (lane & 31)]; }
    LDS_WAIT(); asm volatile("" ::: "memory");
    const int c = lane & 7;
#pragma unroll
    for (int j = 0; j < 4; ++j) { const int n = (lane >> 3) + 8 * j; const LAS float* s = scr + (8 * c) * 33 + n;
        v4u o; o.x = cvt_pk_bf16(s[0 * 33], s[1 * 33]); o.y = cvt_pk_bf16(s[2 * 33], s[3 * 33]); o.z = cvt_pk_bf16(s[4 * 33], s[5 * 33]); o.w = cvt_pk_bf16(s[6 * 33], s[7 * 33]);
        *(GAS v4u*)(WT + (size_t)rm(n0 + n) * ldt + k0 + 8 * c) = o; }
    LDS_WAIT(); asm volatile("" ::: "memory");
}
__device__ __forceinline__ void ln16(f32x4 (&v)[4], const float* g, const float* b, int lane) {
    float s = 0.f;
#pragma unroll
    for (int j = 0; j < 4; ++j) s += (v[j].x + v[j].y) + (v[j].z + v[j].w);
    const float mean = wave_sum(s) * (1.f / D); float s2 = 0.f;
#pragma unroll
    for (int j = 0; j < 4; ++j) { v[j] = v[j] - mean; s2 += (v[j].x * v[j].x + v[j].y * v[j].y) + (v[j].z * v[j].z + v[j].w * v[j].w); }
    const float rstd = 1.f / sqrtf(wave_sum(s2) * (1.f / D) + LN_EPS);
#pragma unroll
    for (int j = 0; j < 4; ++j) { const f32x4 gv = *(const f32x4*)(g + 4 * lane + 256 * j), bv = *(const f32x4*)(b + 4 * lane + 256 * j); v[j] = v[j] * rstd * gv + bv; }
}
__device__ __forceinline__ void store_row(const f32x4 (&v)[4], float* hrow, bf16* brow, int lane) {
#pragma unroll
    for (int j = 0; j < 4; ++j) { *(f32x4*)(hrow + 4 * lane + 256 * j) = v[j]; v2u w; w.x = cvt_pk_bf16(v[j].x, v[j].y); w.y = cvt_pk_bf16(v[j].z, v[j].w); *(v2u*)(brow + 4 * lane + 256 * j) = w; }
}

__device__ __forceinline__ void phase_prologue(Frame& F, CArgs a) {
    LAS float* scr = (LAS float*)(F.lds + RING_OFF + F.wave * 16384);
    const int gw = F.wg * NWAVES + F.wave, NGW = F.G * NWAVES;
    constexpr int I_INS = 16 * 64, I_G = 16 * 128, I_B = 3 * 4 * 32, I_O = 16 * 32, I_GU = NE * 16 * 64, I_D = NE * 16 * 32, I_TOT = I_INS + I_G + I_B + I_O + I_GU + I_D;
    for (int it = gw; it < DEPTH * I_TOT; it += NGW) {
        const int l = it / I_TOT; int r = it - l * I_TOT; unsigned char* wl = a->ws + WS_W0 + (size_t)l * W_LAYER;
        if (r < I_INS) { transpose_item(a->in[3] + (size_t)l * D * IN_COLS, IN_COLS, (bf16*)(wl + WO_INS), D, RmId(), scr, r / 64, r % 64, F.lane); continue; } r -= I_INS;
        if (r < I_G) { transpose_item(a->in[3] + (size_t)l * D * IN_COLS + 2048, IN_COLS, (bf16*)(wl + WO_G), D, RmGate(), scr, r / 128, r % 128, F.lane); continue; } r -= I_G;
        if (r < I_B) { const int g = r / 128, rr = r % 128; transpose_item(a->in[14] + (size_t)(l * 4 + g) * 256 * D, D, (bf16*)(wl + WO_B) + (size_t)g * D * 256, 256, RmId(), scr, rr / 32, rr % 32, F.lane); continue; } r -= I_B;
        if (r < I_O) { transpose_item(a->in[15] + (size_t)l * D * D, D, (bf16*)(wl + WO_O), D, RmId(), scr, r / 32, r % 32, F.lane); continue; } r -= I_O;
        if (r < I_GU) { const int e = r / 1024, rr = r % 1024; transpose_item(a->in[20] + (size_t)(l * NE + e) * D * 2048, 2048, (bf16*)(wl + WO_GU) + (size_t)e * 2048 * D, D, RmGlu(), scr, rr / 64, rr % 64, F.lane); continue; } r -= I_GU;
        { const int e = r / 512, rr = r % 512; transpose_item(a->in[22] + (size_t)(l * NE + e) * D * D, D, (bf16*)(wl + WO_D) + (size_t)e * D * D, D, RmId(), scr, rr / 32, rr % 32, F.lane); }
    }
    const int gt = F.wg * (NWAVES * 64) + F.tid, NT_ = F.G * NWAVES * 64;
    for (int o = gt; o < DEPTH * 262144; o += NT_) {
        const int l = o >> 18, r = o & 262143, d = r >> 8, k = r & 255, grp = k >> 6, c = k & 63;
        const float* pw = a->in[12] + ((size_t)(l * 4 + grp) * 64 + c) * 64; const float* ps = a->in[13] + l * 256 + grp * 64; const float* wb = a->in[14] + ((size_t)(l * 4 + 3) * 256 + grp * 64) * D + d;
        float s = 0.f;
        for (int d2 = 0; d2 < 64; ++d2) s += pw[d2] * ps[d2] * wb[(size_t)d2 * D];
        ((bf16*)(a->ws + WS_W0 + (size_t)l * W_LAYER + WO_B))[(size_t)3 * D * 256 + (size_t)d * 256 + k] = (bf16)(cvt_pk_bf16(s, 0.f) & 0xffffu);
    }
    for (int i = gt; i < 192 * 16; i += NT_) { const int p = i >> 4, fi = i & 15, pp = p < 128 ? p : p - 128;
        double th = (fi & 3) == 0 ? 1.0 : (fi & 3) == 1 ? 0.5623413251903491 : (fi & 3) == 2 ? 0.31622776601683794 : 0.1778279410038923;
        for (int k = 0; k < (fi >> 2); ++k) th *= 0.1;
        const double t2 = th * th; double c = 1.0, s = th, tc = 1.0, tsn = th;
        for (int k = 1; k <= 12; ++k) { tc *= -t2 / (double)((2 * k - 1) * (2 * k)); tsn *= -t2 / (double)((2 * k) * (2 * k + 1)); c += tc; s += tsn; }
        double rc = 1.0, rs = 0.0, bc = c, bs = s;
        for (int n = pp; n > 0; n >>= 1) { if (n & 1) { const double t = rc * bc - rs * bs; rs = rc * bs + rs * bc; rc = t; } const double t = bc * bc - bs * bs; bs = 2.0 * bc * bs; bc = t; }
        float* rope = (float*)(a->ws + WS_ROPE); rope[p * 32 + fi] = (float)rc; rope[p * 32 + 16 + fi] = (float)rs; }
    for (int m = gw; m < M; m += NGW) { f32x4 v[4];
#pragma unroll
        for (int j = 0; j < 4; ++j) v[j] = *(const f32x4*)(a->in[0] + (size_t)m * D + 4 * F.lane + 256 * j);
        ln16(v, a->in[1], a->in[2], F.lane); store_row(v, a->out + (size_t)m * D, (bf16*)(a->ws + WS_HB) + (size_t)m * D, F.lane); }
}

__device__ __forceinline__ void phase_prep(Frame& F, CArgs a, int l) {
    const bf16* zs = (const bf16*)(a->ws + WS_ZS); bf16* qn = (bf16*)(a->ws + WS_QN); bf16* kn = (bf16*)(a->ws + WS_KN); bf16* br = (bf16*)(a->ws + WS_BR);
    {
        LAS float* sbuf = (LAS float*)(F.lds + RING_OFF);
        LAS float* ybuf = (LAS float*)(F.lds + RING_OFF + 65536);
        const float* cw = a->in[8] + l * 31 * 256; const float* lg = a->in[10] + l * 256; const float* lb = a->in[11] + l * 256;
        const int c = F.tid & 255, hf = F.tid >> 8;
        float w[31];
#pragma unroll
        for (int j = 0; j < 31; ++j) w[j] = cw[j * 256 + c];
        const float cbias = a->in[9][l * 256 + c];
        for (int it = F.wg; it < M / 32; it += F.G) {
            const int tok0 = it * 32, p0 = tok0 & (SEQ - 1); const bf16* zb = zs + (size_t)(tok0 - p0) * ZSW;
            for (int task = F.tid; task < 62 * 32; task += NWAVES * 64) {
                const int rr = task >> 5, ck = task & 31, p = p0 - 15 + rr; f32x4 o0 = (f32x4){0.f, 0.f, 0.f, 0.f}, o1 = o0;
                if (p >= 0 && p < SEQ) { float av[8], gv[8]; unpack8(*(const GAS v4u*)(zb + (size_t)p * ZSW + 1280 + ck * 8), av); unpack8(*(const GAS v4u*)(zb + (size_t)p * ZSW + 1536 + ck * 8), gv);
                    o0 = (f32x4){av[0] * sigm(gv[0]), av[1] * sigm(gv[1]), av[2] * sigm(gv[2]), av[3] * sigm(gv[3])}; o1 = (f32x4){av[4] * sigm(gv[4]), av[5] * sigm(gv[5]), av[6] * sigm(gv[6]), av[7] * sigm(gv[7])}; }
                *(LAS f32x4*)(sbuf + rr * 256 + ck * 8) = o0; *(LAS f32x4*)(sbuf + rr * 256 + ck * 8 + 4) = o1;
            }
            __syncthreads();
            float acc[16];
#pragma unroll
            for (int i = 0; i < 16; ++i) acc[i] = 0.f;
#pragma unroll
            for (int j = 0; j < 46; ++j) { const float v = sbuf[(hf * 16 + j) * 256 + c];
#pragma unroll
                for (int i = 0; i < 16; ++i) { if (j - i >= 0 && j - i < 31) acc[i] += w[j - i] * v; } }
#pragma unroll
            for (int i = 0; i < 16; ++i) ybuf[(hf * 16 + i) * 256 + c] = acc[i] + cbias;
            __syncthreads();
#pragma unroll
            for (int q = 0; q < 4; ++q) { const int t = F.wave * 4 + q; f32x4 y = *(const LAS f32x4*)(ybuf + t * 256 + 4 * F.lane);
                const float mean = wave_sum((y.x + y.y) + (y.z + y.w)) * (1.f / 256.f); y = y - mean;
                const float rstd = 1.f / sqrtf(wave_sum((y.x * y.x + y.y * y.y) + (y.z * y.z + y.w * y.w)) * (1.f / 256.f) + LN_EPS);
                const f32x4 o = y * rstd * *(const f32x4*)(lg + 4 * F.lane) + *(const f32x4*)(lb + 4 * F.lane);
                v2u wv; wv.x = cvt_pk_bf16(o.x * sigm(o.x), o.y * sigm(o.y)); wv.y = cvt_pk_bf16(o.z * sigm(o.z), o.w * sigm(o.w));
                *(GAS v2u*)(br + (size_t)(tok0 + t) * 1024 + 512 + 4 * F.lane) = wv; }
            __syncthreads();
        }
    }
    const int gt = F.wg * (NWAVES * 64) + F.tid, NT_ = F.G * NWAVES * 64;
    {
        const float* qg = a->in[5] + l * 64; const float* kg = a->in[6] + l * 64; const float* rope = (const float*)(a->ws + WS_ROPE);
        for (int it = gt; it < M * 6; it += NT_) {
            const int tok = it / 6, hh = it - tok * 6; const bf16* src = zs + (size_t)tok * ZSW + hh * 64;
            float x[64]; float ss = 0.f;
#pragma unroll
            for (int q = 0; q < 8; ++q) { float t8[8]; unpack8(*(const GAS v4u*)(src + q * 8), t8);
#pragma unroll
                for (int i = 0; i < 8; ++i) { x[q * 8 + i] = t8[i]; ss += t8[i] * t8[i]; } }
            const float rinv = 1.f / sqrtf(ss * (1.f / 64.f) + RMS_EPS); const float* gn = hh < 4 ? qg : kg; const float sc = hh < 4 ? QSCALE : 1.f;
#pragma unroll
            for (int i = 0; i < 64; ++i) x[i] *= rinv * gn[i] * sc;
            const int pos = tok & (SEQ - 1); const float* tr = rope + (pos >> 6) * 32; const float* tc = rope + (128 + (pos & 63)) * 32;
            float o[64];
#pragma unroll
            for (int i = 0; i < 16; ++i) { const float cr = tr[i], sr = tr[16 + i], cc = tc[i], sn = tc[16 + i];
                o[i] = x[i] * cr - x[16 + i] * sr; o[16 + i] = x[16 + i] * cr + x[i] * sr; o[32 + i] = x[32 + i] * cc - x[48 + i] * sn; o[48 + i] = x[48 + i] * cc + x[32 + i] * sn; }
            bf16* dst = hh < 4 ? qn + (size_t)tok * 256 + hh * 64 : kn + (size_t)tok * 128 + (hh - 4) * 64;
#pragma unroll
            for (int q = 0; q < 8; ++q) { float t8[8];
#pragma unroll
                for (int i = 0; i < 8; ++i) t8[i] = o[q * 8 + i];
                *(GAS v4u*)(dst + q * 8) = pack8(t8); }
        }
    }
    {
        const float* scw = a->in[7] + l * 3 * 256;
        for (int it = gt; it < M * 32; it += NT_) {
            const int tok = it >> 5, ch = (it & 31) * 8, pos = tok & (SEQ - 1); float acc[8];
#pragma unroll
            for (int i = 0; i < 8; ++i) acc[i] = 0.f;
#pragma unroll
            for (int j = -1; j <= 1; ++j) { const int p = pos + j;
                if (p >= 0 && p < SEQ) { float cg[8], u[8]; unpack8(*(const GAS v4u*)(zs + (size_t)(tok + j) * ZSW + 768 + ch), cg); unpack8(*(const GAS v4u*)(zs + (size_t)(tok + j) * ZSW + 1024 + ch), u);
#pragma unroll
                    for (int i = 0; i < 8; ++i) acc[i] += scw[(j + 1) * 256 + ch + i] * (cg[i] * u[i]); } }
            float bg[8]; unpack8(*(const GAS v4u*)(zs + (size_t)tok * ZSW + 512 + ch), bg);
#pragma unroll
            for (int i = 0; i < 8; ++i) acc[i] *= bg[i];
            *(GAS v4u*)(br + (size_t)tok * 1024 + 256 + ch) = pack8(acc);
        }
    }
    {
        for (int it = gt; it < M * 32; it += NT_) {
            const int tok = it >> 5, ch = (it & 31) * 8, pos = tok & (SEQ - 1), grp = ch >> 6, w = 2 << grp;
            const int lo = (pos - (w >> 1)) > 0 ? (pos - (w >> 1)) : 0, hi = (pos + (w - 1 - (w >> 1))) < (SEQ - 1) ? (pos + (w - 1 - (w >> 1))) : (SEQ - 1);
            float s[8];
#pragma unroll
            for (int i = 0; i < 8; ++i) s[i] = 0.f;
            for (int p = lo; p <= hi; ++p) { float u[8]; unpack8(*(const GAS v4u*)(zs + (size_t)(tok - pos + p) * ZSW + 1792 + ch), u);
#pragma unroll
                for (int i = 0; i < 8; ++i) s[i] += u[i]; }
            const float inv = 1.f / (float)(hi - lo + 1); float uc[8]; unpack8(*(const GAS v4u*)(zs + (size_t)tok * ZSW + 1792 + ch), uc);
#pragma unroll
            for (int i = 0; i < 8; ++i) s[i] = s[i] * inv - uc[i];
            *(GAS v4u*)(br + (size_t)tok * 1024 + 768 + ch) = pack8(s);
        }
    }
}

__device__ __forceinline__ void phase_ln_router(Frame& F, CArgs a, int l) {
    LAS float* wrT = (LAS float*)(F.lds + RING_OFF);
    LAS unsigned* hist = (LAS unsigned*)(F.lds + HIST_OFF); LAS float* lgs = (LAS float*)(F.lds + LG_OFF) + F.wave * 64;
    const float* wr = a->in[18] + (size_t)l * D * NE; const float* brt = a->in[19] + l * NE;
    for (int idx = F.tid; idx < NE * D; idx += NWAVES * 64) { const int e = idx >> 10, d = idx & 1023; wrT[idx] = wr[d * NE + e]; }
    if (F.tid < NE) hist[F.tid] = 0u;
    __syncthreads();
    float* H = a->out; bf16* hb = (bf16*)(a->ws + WS_HB); int* topE = (int*)(a->ws + WS_TOPE); float* topW = (float*)(a->ws + WS_TOPW); int* topR = (int*)(a->ws + WS_TOPR);
    const float* g1 = a->in[16] + l * D; const float* b1 = a->in[17] + l * D;
    const int TPW = M / F.G, tok_lo = F.wg * TPW;
    for (int r0 = F.wave * 2; r0 < TPW; r0 += NWAVES * 2) {
        const int tokA = tok_lo + r0;
        f32x4 v[2][4];
#pragma unroll
        for (int rr = 0; rr < 2; ++rr) {
#pragma unroll
            for (int j = 0; j < 4; ++j) v[rr][j] = *(const f32x4*)(H + (size_t)(tokA + rr) * D + 4 * F.lane + 256 * j);
            ln16(v[rr], g1, b1, F.lane); store_row(v[rr], H + (size_t)(tokA + rr) * D, hb + (size_t)(tokA + rr) * D, F.lane); }
        float p0[32], p1[32];
#pragma unroll
        for (int e = 0; e < 32; ++e) { float s0 = 0.f, s1 = 0.f;
#pragma unroll
            for (int j = 0; j < 4; ++j) { const f32x4 w4 = *(const LAS f32x4*)(wrT + e * 1024 + 256 * j + 4 * F.lane);
                s0 += (v[0][j].x * w4.x + v[0][j].y * w4.y) + (v[0][j].z * w4.z + v[0][j].w * w4.w); s1 += (v[1][j].x * w4.x + v[1][j].y * w4.y) + (v[1][j].z * w4.z + v[1][j].w * w4.w); }
            p0[e] = s0; p1[e] = s1; }
#define RT_STEP(OFF, HALFN) { const bool up = (F.lane & (OFF)) != 0; _Pragma("unroll") for (int i = 0; i < (HALFN); ++i) { \
            const float k0 = up ? p0[i + (HALFN)] : p0[i], s0 = up ? p0[i] : p0[i + (HALFN)]; p0[i] = k0 + __shfl_xor(s0, (OFF)); \
            const float k1 = up ? p1[i + (HALFN)] : p1[i], s1 = up ? p1[i] : p1[i + (HALFN)]; p1[i] = k1 + __shfl_xor(s1, (OFF)); } }
        RT_STEP(32, 16) RT_STEP(16, 8) RT_STEP(8, 4) RT_STEP(4, 2) RT_STEP(2, 1)
#undef RT_STEP
        const int le = F.lane >> 1; const float be = brt[le];
        const float lgA = p0[0] + __shfl_xor(p0[0], 1) + be, lgB = p1[0] + __shfl_xor(p1[0], 1) + be;
        if ((F.lane & 1) == 0) { lgs[le] = lgA; lgs[32 + le] = lgB; }
        LDS_WAIT(); asm volatile("" ::: "memory");
        const int rsel = F.lane >> 5; const LAS float* lr = lgs + rsel * 32;
        float v0 = -INFINITY, v1 = -INFINITY, v2 = -INFINITY, v3 = -INFINITY; int i0 = 0, i1 = 0, i2 = 0, i3 = 0;
#pragma unroll
        for (int e = 0; e < 32; ++e) { const float x = lr[e];
            if (x > v3) { if (x > v0) { v3 = v2; i3 = i2; v2 = v1; i2 = i1; v1 = v0; i1 = i0; v0 = x; i0 = e; }
                          else if (x > v1) { v3 = v2; i3 = i2; v2 = v1; i2 = i1; v1 = x; i1 = e; }
                          else if (x > v2) { v3 = v2; i3 = i2; v2 = x; i2 = e; }
                          else { v3 = x; i3 = e; } } }
        LDS_WAIT(); asm volatile("" ::: "memory");
        if ((F.lane & 31) == 0) {
            const float e1 = __expf(v1 - v0), e2 = __expf(v2 - v0), e3 = __expf(v3 - v0), inv = 1.f / (1.f + e1 + e2 + e3); const int tok = tokA + rsel;
            const unsigned k0 = __hip_atomic_fetch_add(hist + i0, 1u, __ATOMIC_RELAXED, __HIP_MEMORY_SCOPE_WORKGROUP), k1 = __hip_atomic_fetch_add(hist + i1, 1u, __ATOMIC_RELAXED, __HIP_MEMORY_SCOPE_WORKGROUP);
            const unsigned k2 = __hip_atomic_fetch_add(hist + i2, 1u, __ATOMIC_RELAXED, __HIP_MEMORY_SCOPE_WORKGROUP), k3 = __hip_atomic_fetch_add(hist + i3, 1u, __ATOMIC_RELAXED, __HIP_MEMORY_SCOPE_WORKGROUP);
            *(int4*)(topE + tok * 4) = make_int4(i0, i1, i2, i3); *(float4*)(topW + tok * 4) = make_float4(inv, e1 * inv, e2 * inv, e3 * inv); *(int4*)(topR + tok * 4) = make_int4((int)k0, (int)k1, (int)k2, (int)k3);
        }
    }
    __syncthreads();
    if (F.tid < NE) { const unsigned base = __hip_atomic_fetch_add(F.ctl + CW_CNT + 32 * l + F.tid, hist[F.tid], RLX_AGENT); ((int*)(a->ws + WS_WGB))[F.wg * NE + F.tid] = (int)base; }
}
__device__ __forceinline__ void build_moe_tab(Frame& F, int l, int nct) {
    LAS int* tab = (LAS int*)(F.lds + TAB_OFF);
    if (F.tid == 0) { int cu = 0, ts = 0;
        for (int e = 0; e < NE; ++e) { const int cnt = (int)__hip_atomic_load(F.ctl + CW_CNT + 32 * l + e, RLX_AGENT), nt = (cnt + 255) >> 8; tab[e] = cu; tab[33 + e] = ts; cu += nt * nct; ts += nt; }
        tab[32] = cu; tab[65] = ts; }
    __syncthreads();
}
__device__ __forceinline__ void phase_scatter(Frame& F, CArgs a, int l) {
    build_moe_tab(F, l, 8);
    const LAS int* tab = (const LAS int*)(F.lds + TAB_OFF);
    const bf16* hb = (const bf16*)(a->ws + WS_HB); bf16* xs = (bf16*)(a->ws + WS_XS); const int* topE = (const int*)(a->ws + WS_TOPE); int* topR = (int*)(a->ws + WS_TOPR); const int* wgb = (const int*)(a->ws + WS_WGB) + F.wg * NE;
    const int TPW = M / F.G, tok_lo = F.wg * TPW;
    for (int r = F.wave; r < TPW; r += NWAVES) {
        const int tok = tok_lo + r; int pos = 0;
        if (F.lane < 4) { const int e = topE[tok * 4 + F.lane]; pos = tab[33 + e] * 256 + wgb[e] + topR[tok * 4 + F.lane]; }
        const v4u x0 = *(const GAS v4u*)(hb + (size_t)tok * D + 8 * F.lane), x1 = *(const GAS v4u*)(hb + (size_t)tok * D + 512 + 8 * F.lane);
#pragma unroll
        for (int k = 0; k < 4; ++k) { const int pk = __shfl(pos, k); *(GAS v4u*)(xs + (size_t)pk * D + 8 * F.lane) = x0; *(GAS v4u*)(xs + (size_t)pk * D + 512 + 8 * F.lane) = x1; }
        if (F.lane < 4) topR[tok * 4 + F.lane] = pos;
    }
}
__device__ __forceinline__ void phase_combine(Frame& F, CArgs a, int l) {
    float* H = a->out; bf16* hb = (bf16*)(a->ws + WS_HB); const bf16* Y = (const bf16*)(a->ws + WS_Y); const float* topW = (const float*)(a->ws + WS_TOPW); const int* topR = (const int*)(a->ws + WS_TOPR);
    const float* g2 = a->in[24] + l * D; const float* b2 = a->in[25] + l * D;
    const int gw = F.wg * NWAVES + F.wave, NGW = F.G * NWAVES;
    for (int tok = gw; tok < M; tok += NGW) {
        const int4 ps = *(const int4*)(topR + tok * 4); const float4 ws = *(const float4*)(topW + tok * 4);
        const int pk[4] = {ps.x, ps.y, ps.z, ps.w}; const float wk[4] = {ws.x, ws.y, ws.z, ws.w};
        f32x4 v[4];
#pragma unroll
        for (int j = 0; j < 4; ++j) { v[j] = *(const f32x4*)(H + (size_t)tok * D + 4 * F.lane + 256 * j) * DN_ALPHA;
#pragma unroll
            for (int k = 0; k < 4; ++k) { const v2u y = *(const GAS v2u*)(Y + (size_t)pk[k] * D + 4 * F.lane + 256 * j); v[j].x += wk[k] * bflo(y.x); v[j].y += wk[k] * bfhi(y.x); v[j].z += wk[k] * bflo(y.y); v[j].w += wk[k] * bfhi(y.y); } }
        ln16(v, g2, b2, F.lane); store_row(v, H + (size_t)tok * D, hb + (size_t)tok * D, F.lane);
    }
}

__global__ void __launch_bounds__(NWAVES * 64, 2) mk_fwd(Args args) {
    extern __shared__ __attribute__((aligned(16))) unsigned char lds[];
    Frame F;
    F.lds = (LAS unsigned char*)lds; F.MISC = (volatile LAS unsigned*)(F.lds + MISC_OFF);
    F.tid = threadIdx.x; F.lane = F.tid & 63; F.wave = __builtin_amdgcn_readfirstlane(F.tid >> 6);
    F.G = gridDim.x; F.wg = blockIdx.x; { const int bx = blockIdx.x; F.vcu = (F.G % 8 == 0) ? (bx % 8) * (F.G / 8) + bx / 8 : bx; }
    CArgs ap = (CArgs)__builtin_amdgcn_kernarg_segment_ptr();
    F.ctl = (gu32*)(ap->ws + WS_CTL);
    for (int u = F.tid; u < (LDS_BYTES - LDSCTL_OFF) / 4; u += NWAVES * 64) ((LAS unsigned*)(F.lds + LDSCTL_OFF))[u] = 0u;
    __syncthreads();
#if MK_ONE_LAUNCH
    XcdBarrier bar = xcd_barrier_post((unsigned*)(F.ctl + CW_BAR), F.MISC + 8);
#define GRID_BAR() do { asm volatile("" : "+s"(bar.bar)); xcd_barrier(bar); } while (0)
#else
#define GRID_BAR() do { } while (0)
#endif
    const int lo = args.ph_lo, hi = args.ph_hi;
#ifndef PH_MASK
#define PH_MASK 0xfff
#endif
#define IN(k) (lo <= (k) && (k) < hi)
#define ON(s) (((PH_MASK) >> (s)) & 1)
#define FRESH() do { asm volatile("" : "+v"(F.tid), "+v"(F.lane)); asm volatile("" : "+s"(ap)); asm volatile("" : "+s"(F.wg)); asm volatile("" : "+s"(F.G)); asm volatile("" : "+s"(F.vcu)); } while (0)
#define SEAM(k) do { if (IN((k) + 1)) GRID_BAR(); } while (0)
#define WSP (ap->ws)
#define WLP (ap->ws + WS_W0 + (size_t)l * W_LAYER)
    if (ON(11) && IN(0)) { FRESH(); phase_prologue(F, ap); SEAM(0); }
#pragma unroll 1
    for (int l = 0; l < DEPTH; ++l) {
        const int pb = 1 + NSUB * l;
        if (ON(0) && IN(pb + 0)) { FRESH();
            pg8::Gemm g{(const pg8::bf16_t*)(WSP + WS_HB), (const pg8::bf16_t*)(WLP + WO_INS), M, ZSW, D, D, D}; pg8::StaticOrder S; S.init(M, ZSW, F.G, F.wg);
            pg8::EpiBf16<0> E{(pg8::bf16_t*)(WSP + WS_ZS), ZSW, ap->in[4] + l * IN_COLS, 0, 0, 1.f};
            pg8::gemm_phase<pg8::EpiBf16<0>, pg8::StaticOrder, true, true>(F.lds + RING_OFF, g, S, E); SEAM(pb + 0); }
        if (ON(1) && IN(pb + 1)) { FRESH(); phase_prep(F, ap, l); SEAM(pb + 1); }
        if (ON(2) && IN(pb + 2)) { FRESH();
            const attn_body::AttnTensors AT{(const attn_body::bf16*)(WSP + WS_QN), (const attn_body::bf16*)(WSP + WS_KN), (const attn_body::bf16*)(WSP + WS_ZS) + 384, (attn_body::bf16*)(WSP + WS_BR)};
            const attn_body::StaticOrder S(F.vcu);
            attn_body::attn_phase<attn_body::StaticOrder>((char*)lds + RING_OFF, AT, S); SEAM(pb + 2); }
        if (ON(3) && IN(pb + 3)) { FRESH();
            pg8::Gemm g{(const pg8::bf16_t*)(WSP + WS_BR), (const pg8::bf16_t*)(WLP + WO_B), M, 4096, 256, D, 256}; pg8::BranchOrder S; S.init(M, 4096, F.G, F.wg);
            pg8::EpiBf16<0> E{(pg8::bf16_t*)(WSP + WS_P), 4096, nullptr, 0, 0, 1.f};
            pg8::gemm_phase<pg8::EpiBf16<0>, pg8::BranchOrder, true, true>(F.lds + RING_OFF, g, S, E); SEAM(pb + 3); }
        if (ON(4) && IN(pb + 4)) { FRESH();
            pg8::Gemm g{(const pg8::bf16_t*)(WSP + WS_HB), (const pg8::bf16_t*)(WLP + WO_G), M, 4096, D, D, D}; pg8::StaticOrder S; S.init(M, 4096, F.G, F.wg);
            pg8::EpiGate E{(const pg8::bf16_t*)(WSP + WS_P), ap->in[4] + l * IN_COLS + 2048, (pg8::bf16_t*)(WSP + WS_MG)};
            pg8::gemm_phase<pg8::EpiGate, pg8::StaticOrder, true, true>(F.lds + RING_OFF, g, S, E); SEAM(pb + 4); }
        if (ON(5) && IN(pb + 5)) { FRESH();
            pg8::Gemm g{(const pg8::bf16_t*)(WSP + WS_MG), (const pg8::bf16_t*)(WLP + WO_O), M, D, D, D, D}; pg8::StaticOrder S; S.init(M, D, F.G, F.wg);
            pg8::EpiResid E{ap->out, DN_ALPHA};
            pg8::gemm_phase<pg8::EpiResid, pg8::StaticOrder, true, true>(F.lds + RING_OFF, g, S, E); SEAM(pb + 5); }
        if (ON(6) && IN(pb + 6)) { FRESH(); phase_ln_router(F, ap, l); SEAM(pb + 6); }
        if (ON(7) && IN(pb + 7)) { FRESH(); phase_scatter(F, ap, l); SEAM(pb + 7); }
        if (ON(8) && IN(pb + 8)) { FRESH();
            build_moe_tab(F, l, 8);
            pg8::Gemm g{(const pg8::bf16_t*)(WSP + WS_XS), (const pg8::bf16_t*)(WLP + WO_GU), RMAX, 2048 * NE, D, D, D}; pg8::MoeOrder S{(const LAS int*)(F.lds + TAB_OFF), 8, F.G, F.wg};
            pg8::EpiSwiglu E{(pg8::bf16_t*)(WSP + WS_HA), ap->in[21] + (size_t)l * NE * 2048};
            pg8::gemm_phase<pg8::EpiSwiglu, pg8::MoeOrder, true, true>(F.lds + RING_OFF, g, S, E); SEAM(pb + 8); }
        if (ON(9) && IN(pb + 9)) { FRESH();
            build_moe_tab(F, l, 4);
            pg8::Gemm g{(const pg8::bf16_t*)(WSP + WS_HA), (const pg8::bf16_t*)(WLP + WO_D), RMAX, D * NE, D, D, D}; pg8::MoeOrder S{(const LAS int*)(F.lds + TAB_OFF), 4, F.G, F.wg};
            pg8::EpiDown E{(pg8::bf16_t*)(WSP + WS_Y), ap->in[23] + (size_t)l * NE * D};
            pg8::gemm_phase<pg8::EpiDown, pg8::MoeOrder, true, true>(F.lds + RING_OFF, g, S, E); SEAM(pb + 9); }
        if (ON(10) && IN(pb + 10)) { FRESH(); phase_combine(F, ap, l); SEAM(pb + 10); }
    }
#undef IN
#undef SEAM
#undef WSP
#undef WLP
}

extern "C" void kernel_launch(void* const* d_in, const int* in_sizes, int n_in, void* d_out, int out_size, void* d_ws, size_t ws_size, hipStream_t stream) {
    static int grid = 0;
    if (grid == 0) {
        if (n_in != 26 || in_sizes[0] != M * D || out_size != M * D || ws_size < WS_END) { fprintf(stderr, "kernel_launch: unexpected shapes (n_in %d, in0 %d, out %d, ws %zu < %zu?); nothing launched\n", n_in, n_in > 0 ? in_sizes[0] : -1, out_size, ws_size, (size_t)WS_END); grid = -1; return; }
        if (hipFuncSetAttribute((const void*)mk_fwd, hipFuncAttributeMaxDynamicSharedMemorySize, LDS_BYTES) != hipSuccess) { fprintf(stderr, "kernel_launch: hipFuncSetAttribute failed\n"); grid = -1; return; }
        int per_cu = 0;
        if (hipOccupancyMaxActiveBlocksPerMultiprocessor(&per_cu, (const void*)mk_fwd, NWAVES * 64, LDS_BYTES) != hipSuccess || per_cu < 1) fprintf(stderr, "kernel_launch: note: occupancy query reports %d workgroups per CU\n", per_cu);
        (void)hipGetLastError();
        grid = 256;
    }
    if (grid < 0) return;
    if (hipMemsetAsync((char*)d_ws + WS_CTL, 0, CTL_ZERO_BYTES, stream) != hipSuccess) { fprintf(stderr, "kernel_launch: memset failed\n"); return; }
    Args a{};
    for (int i = 0; i < 26; ++i) a.in[i] = (const float*)d_in[i];
    a.out = (float*)d_out; a.ws = (unsigned char*)d_ws;
#if MK_ONE_LAUNCH
    a.ph_lo = 0; a.ph_hi = NPH;
    hipLaunchKernelGGL(mk_fwd, dim3(grid), dim3(NWAVES * 64), LDS_BYTES, stream, a);
#else
    for (int p = 0; p < NPH; ++p) { a.ph_lo = p; a.ph_hi = p + 1; hipLaunchKernelGGL(mk_fwd, dim3(grid), dim3(NWAVES * 64), LDS_BYTES, stream, a); }
#endif
    const hipError_t le = hipPeekAtLastError();
    if (le != hipSuccess) fprintf(stderr, "kernel_launch: launch failed: %s\n", hipGetErrorName(le));
}
```

```cpp
#include <hip/hip_runtime.h>
#include <cstdio>
#include <cstdint>
#include <hip/hip_runtime.h>
#include <cstdio>
#include <cstdint>
namespace pg8 {
#define PG8_LAS __attribute__((address_space(3)))
typedef unsigned short bf16_t;
typedef short bf16x8 __attribute__((ext_vector_type(8)));
typedef float f32x4 __attribute__((ext_vector_type(4)));
typedef unsigned u32x4 __attribute__((ext_vector_type(4)));
typedef int i32x4 __attribute__((ext_vector_type(4)));
typedef int i32x8 __attribute__((ext_vector_type(8)));
constexpr int BM = 256, BK = 64, HALF = 128, HTB = HALF * BK * 2  , STAGE_BYTES = 8 * HTB, NXCD = 8, WGM = 8;

__host__ __device__ __forceinline__ int lds_byte(int r, int c) { const int st = (r >> 4) * 2 + (c >> 5), rr = r & 15, cc = c & 31, ob = rr * 64 + cc * 2; return st * 1024 + (ob ^ (((ob >> 9) & 1) << 5)); }
__host__ __device__ __forceinline__ void stage_rc(int b, int& R, int& C) { const int st = b / 1024, sb = b % 1024, swz = sb ^ (((sb >> 9) & 1) << 5); R = (st >> 1) * 16 + swz / 64; C = (st & 1) * 32 + (swz % 64) / 2; }
__host__ __device__ __forceinline__ int perm32(int rho) { const int n = rho >> 4, i = rho & 15; return 8 * (i >> 2) + 4 * n + (i & 3); }

struct Unit { int pm, pn, ka; };
struct Gemm { const bf16_t* A; const bf16_t* Bt; int M, N, K, lda, ldb; };

struct StaticOrder {
    int nM, nN, nwg, G, c;
    __host__ __device__ void init(int M, int N, int G_, int c_) { nM = M / BM; nN = N / BM; nwg = nM * nN; G = G_; c = c_; }
    __host__ __device__ bool next(int i, Unit& u) const {
        const long L = (long)i * G + c; if (L >= nwg) return false;
        int wgid = (int)L; { const int q = nwg / NXCD, r = nwg % NXCD, xcd = wgid % NXCD, off = wgid / NXCD; wgid = (xcd < r ? xcd * (q + 1) : r * (q + 1) + (xcd - r) * q) + off; }
        const int nig = WGM * nN, gid = wgid / nig, fm = gid * WGM, gsz = (nM - fm) < WGM ? (nM - fm) : WGM;
        u.pm = fm + ((wgid % nig) % gsz); u.pn = (wgid % nig) / gsz; u.ka = 0; return true;
    }
    __device__ __forceinline__ void a_ready(const Unit&) const {}
    __device__ __forceinline__ void done(const Unit&) const {}
};

__device__ __forceinline__ unsigned cvt_pk_bf16(float lo, float hi) { unsigned r; asm volatile("v_cvt_pk_bf16_f32 %0, %1, %2" : "=v"(r) : "v"(lo), "v"(hi)); return r; }
typedef float f32x2 __attribute__((ext_vector_type(2)));
__device__ __forceinline__ f32x2 gelu_pk(f32x2 v) {
    const f32x2 av = __builtin_elementwise_abs(v), d = av * 0.2316418882f + 1.0f;
    f32x2 t; t.x = __builtin_amdgcn_rcpf(d.x); t.y = __builtin_amdgcn_rcpf(d.y);
    f32x2 q = t * 0.5307027145f + (-0.7265760135f); q = q * t + 0.7107068705f; q = q * t + (-0.142248368f); q = q * t + 0.127414796f; q = q * t;
    const f32x2 s = (v * v) * (-0.72134752044f);
    f32x2 e; e.x = __builtin_amdgcn_exp2f(s.x); e.y = __builtin_amdgcn_exp2f(s.y);
    const f32x2 m = v * (q * e), r = v - m;
    f32x2 o; o.x = v.x < 0.f ? m.x : r.x; o.y = v.y < 0.f ? m.y : r.y; return o;
}

template <int ACT  > struct EpiBf16 {
    static constexpr bool PERM = true, AFTER_DRAIN = false; static_assert(ACT == 0 || ACT == 1, "EpiBf16: ACT is 0 (none) or 1 (gelu_pk)");
    bf16_t* O; int ldc; const float* bias; int split_cols; size_t split_stride; float scale0;
    __device__ __forceinline__ void operator()(const f32x4 (&acc)[2][2][4][2], const Unit& u, int wr, int wc, int fr, int fq) const {
        const int row0 = u.pm * BM + wr * 64 + fr; int colt = u.pn * BM; bf16_t* base = O;
        float sc = 1.f; if (split_cols) { const int t = colt / split_cols; base += (size_t)t * split_stride; colt -= t * split_cols; if (t == 0) sc = scale0; }
        const int col0 = colt + wc * 32 + 8 * fq, bcol0 = u.pn * BM + wc * 32 + 8 * fq;
        f32x4 bv[2][2];
#pragma unroll
        for (int bj = 0; bj < 2; ++bj)
#pragma unroll
            for (int n = 0; n < 2; ++n) bv[bj][n] = bias ? *(const f32x4*)(bias + bcol0 + bj * HALF + 4 * n) : (f32x4){0.f, 0.f, 0.f, 0.f};
#pragma unroll
        for (int ai = 0; ai < 2; ++ai)
#pragma unroll
            for (int m = 0; m < 4; ++m) { bf16_t* rowp = base + (size_t)(row0 + ai * HALF + m * 16) * ldc + col0;
#pragma unroll
                for (int bj = 0; bj < 2; ++bj) { f32x4 v0 = acc[ai][bj][m][0] + bv[bj][0], v1 = acc[ai][bj][m][1] + bv[bj][1];
                    if (ACT == 1) { f32x2 a = gelu_pk((f32x2){v0[0], v0[1]}), b = gelu_pk((f32x2){v0[2], v0[3]}), c = gelu_pk((f32x2){v1[0], v1[1]}), d = gelu_pk((f32x2){v1[2], v1[3]});
                        v0 = (f32x4){a.x, a.y, b.x, b.y}; v1 = (f32x4){c.x, c.y, d.x, d.y}; }
                    v0 = v0 * sc; v1 = v1 * sc; u32x4 w; w.x = cvt_pk_bf16(v0[0], v0[1]); w.y = cvt_pk_bf16(v0[2], v0[3]); w.z = cvt_pk_bf16(v1[0], v1[1]); w.w = cvt_pk_bf16(v1[2], v1[3]);
                    *(u32x4*)(rowp + bj * HALF) = w; } }
    }
};

typedef int i32x32 __attribute__((ext_vector_type(32)));
template <int P> __device__ __forceinline__ i32x8 ex8(const i32x32& v) { return __builtin_shufflevector(v, v, P, P + 1, P + 2, P + 3, P + 4, P + 5, P + 6, P + 7); }
template <int P> __device__ __forceinline__ void ins4(i32x32& v, const i32x4 x) { v[P] = x[0]; v[P + 1] = x[1]; v[P + 2] = x[2]; v[P + 3] = x[3]; }
template <class Epi, class Sched, bool ALIGN_EPI = false, bool SP2 = false, bool F8 = false>
__device__ __forceinline__ void gemm_phase(PG8_LAS unsigned char* lds, const Gemm g, const Sched& S, const Epi& E) {
    int tid_ = threadIdx.x; asm volatile("" : "+v"(tid_));
    const int tid = tid_, wid = __builtin_amdgcn_readfirstlane(tid >> 6), lane = tid & 63, wr = wid >> 2, wc = wid & 3, fr = lane & 15, fq = lane >> 4;
    constexpr int EB = F8 ? 1 : 2;
    const int K = g.K, nt = K * EB / (BK * 2);
    unsigned voffA[2], voffB[2];
#pragma unroll
    for (int i = 0; i < 2; ++i) { int R, C; stage_rc(tid * 16 + i * 8192, R, C); const int Rb = Epi::PERM ? ((R & ~31) + perm32(R & 31)) : R;
        voffA[i] = (unsigned)(R * g.lda * EB + C * 2); voffB[i] = (unsigned)(Rb * g.ldb * EB + C * 2); }
    const size_t kstep = (size_t)(BK * 2);
    const size_t hstepA = (size_t)HALF * g.lda * EB, hstepB = (size_t)HALF * g.ldb * EB;
    const size_t tstepA = 2 * hstepA, tstepB = 2 * hstepB;
    const unsigned ldsw = (unsigned)wid * 1024u;
    const int aoff = lds_byte(wr * 64 + fr, fq * 8), boff = lds_byte(wc * 32 + fr, fq * 8);
    unsigned bbase_ = (unsigned)(size_t)lds + 65536u + (unsigned)boff; asm volatile("" : "+v"(bbase_)); const PG8_LAS unsigned char* ldsb = (const PG8_LAS unsigned char*)(size_t)bbase_;
#define PG8_SA(b, h) (((b) * 2 + (h)) * HTB)
#define PG8_SB(b, h) ((4 + (b) * 2 + (h)) * HTB)
#define PG8_STAGE(bufoff, gbase, voff) do { _Pragma("unroll") for (int _i = 0; _i < 2; ++_i) \
        __builtin_amdgcn_global_load_lds((const unsigned*)((const char*)(gbase) + (voff)[_i]), (PG8_LAS unsigned*)(lds + (bufoff) + ldsw + _i * 8192), 16, 0, 0); } while (0)
#define PG8_LD16(off) (*(const PG8_LAS i32x4*)(lds + (off)))
#define PG8_LDA(dst, b, h) do { if constexpr (F8) { ins4<0>(FA, PG8_LD16(PG8_SA(b, h) + aoff)); ins4<4>(FA, PG8_LD16(PG8_SA(b, h) + aoff + 1024)); ins4<8>(FA, PG8_LD16(PG8_SA(b, h) + aoff + 2048)); ins4<12>(FA, PG8_LD16(PG8_SA(b, h) + aoff + 3072)); \
            ins4<16>(FA, PG8_LD16(PG8_SA(b, h) + aoff + 4096)); ins4<20>(FA, PG8_LD16(PG8_SA(b, h) + aoff + 5120)); ins4<24>(FA, PG8_LD16(PG8_SA(b, h) + aoff + 6144)); ins4<28>(FA, PG8_LD16(PG8_SA(b, h) + aoff + 7168)); } \
        else { _Pragma("unroll") for (int m = 0; m < 4; ++m) _Pragma("unroll") for (int k = 0; k < 2; ++k) dst[m][k] = *(const PG8_LAS bf16x8*)(lds + PG8_SA(b, h) + aoff + m * 2048 + k * 1024); } } while (0)
#define PG8_LDB16(off) (*(const PG8_LAS i32x4*)(ldsb + (off)))
#define PG8_FBOFF_B0 0
#define PG8_FBOFF_B1 16
#define PG8_LDB(dst, b, h) do { if constexpr (F8) { ins4<PG8_FBOFF_##dst>(FB, PG8_LDB16(PG8_SB(b, h) - 65536)); ins4<PG8_FBOFF_##dst + 4>(FB, PG8_LDB16(PG8_SB(b, h) - 65536 + 1024)); \
            ins4<PG8_FBOFF_##dst + 8>(FB, PG8_LDB16(PG8_SB(b, h) - 65536 + 2048)); ins4<PG8_FBOFF_##dst + 12>(FB, PG8_LDB16(PG8_SB(b, h) - 65536 + 3072)); } \
        else { _Pragma("unroll") for (int n = 0; n < 2; ++n) _Pragma("unroll") for (int k = 0; k < 2; ++k) dst[n][k] = *(const PG8_LAS bf16x8*)(ldsb + PG8_SB(b, h) - 65536 + n * 2048 + k * 1024); } } while (0)
#define PG8_MF8(ai, bj, m, n, Bt) do { const i32x8 b_ = ex8<PG8_FBOFF_##Bt + 8 * (n)>(FB), a_ = ex8<8 * (m)>(FA); asm volatile("v_mfma_f32_16x16x128_f8f6f4 %0, %1, %2, %0" : "+v"(acc[ai][bj][m][n]) : "v"(b_), "v"(a_)); } while (0)
#define PG8_MMA(ai, bj, At, Bt) do { __builtin_amdgcn_s_setprio(1); \
        if constexpr (F8) { PG8_MF8(ai, bj, 0, 0, Bt); PG8_MF8(ai, bj, 0, 1, Bt); PG8_MF8(ai, bj, 1, 0, Bt); PG8_MF8(ai, bj, 1, 1, Bt); PG8_MF8(ai, bj, 2, 0, Bt); PG8_MF8(ai, bj, 2, 1, Bt); PG8_MF8(ai, bj, 3, 0, Bt); PG8_MF8(ai, bj, 3, 1, Bt); } \
        else { _Pragma("unroll") for (int m = 0; m < 4; ++m) _Pragma("unroll") for (int n = 0; n < 2; ++n) _Pragma("unroll") for (int k = 0; k < 2; ++k) acc[ai][bj][m][n] = __builtin_amdgcn_mfma_f32_16x16x32_bf16(Bt[n][k], At[m][k], acc[ai][bj][m][n], 0, 0, 0); } __builtin_amdgcn_s_setprio(0); } while (0)
#define PG8_WAIT_V(n) asm volatile("s_waitcnt vmcnt(" #n ")" ::: "memory")
#define PG8_WAIT_L(n) asm volatile("s_waitcnt lgkmcnt(" #n ")" ::: "memory")
#define PG8_BAR __builtin_amdgcn_s_barrier()
#define PG8_SCHED __builtin_amdgcn_sched_barrier(0)
    Unit cur, nxt; int ui = 0;
    if (!S.next(0, cur)) return;
    f32x4 acc[2][2][4][2];
#pragma unroll
    for (int a = 0; a < 2; ++a)
#pragma unroll
        for (int b = 0; b < 2; ++b)
#pragma unroll
            for (int m = 0; m < 4; ++m)
#pragma unroll
                for (int n = 0; n < 2; ++n) acc[a][b][m][n] = (f32x4){0.f, 0.f, 0.f, 0.f};
    bf16x8 At[4][2], B0[2][2], B1[2][2]; i32x32 FA, FB;
    const char* cA = (const char*)g.A + (size_t)cur.pm * tstepA + (size_t)cur.ka * EB; const char* cB = (const char*)g.Bt + (size_t)cur.pn * tstepB;
    S.a_ready(cur);
    if constexpr (SP2) {
        PG8_STAGE(PG8_SB(0, 0), cB, voffB); PG8_STAGE(PG8_SB(0, 1), cB + hstepB, voffB); PG8_STAGE(PG8_SA(0, 0), cA, voffA); PG8_STAGE(PG8_SA(0, 1), cA + hstepA, voffA);
        if (wr == 1) PG8_BAR;
        PG8_WAIT_V(2); PG8_BAR;
        PG8_STAGE(PG8_SB(1, 0), cB + kstep, voffB); PG8_STAGE(PG8_SA(1, 0), cA + kstep, voffA); PG8_STAGE(PG8_SB(1, 1), cB + hstepB + kstep, voffB);
        PG8_WAIT_V(6); PG8_BAR;
    } else {
        PG8_STAGE(PG8_SB(0, 0), cB, voffB); PG8_STAGE(PG8_SA(0, 0), cA, voffA); PG8_STAGE(PG8_SB(0, 1), cB + hstepB, voffB); PG8_STAGE(PG8_SA(0, 1), cA + hstepA, voffA);
        if (wr == 1) PG8_BAR;
        PG8_WAIT_V(4); PG8_BAR;
        PG8_STAGE(PG8_SB(1, 0), cB + kstep, voffB); PG8_STAGE(PG8_SA(1, 0), cA + kstep, voffA); PG8_STAGE(PG8_SB(1, 1), cB + hstepB + kstep, voffB);
        PG8_WAIT_V(6); PG8_BAR;
    }
    for (;;) {
        const bool has_next = S.next(ui + 1, nxt);
        const char* nA = has_next ? (const char*)g.A + (size_t)nxt.pm * tstepA + (size_t)nxt.ka * EB : cA; const char* nB = has_next ? (const char*)g.Bt + (size_t)nxt.pn * tstepB : cB;
#pragma unroll 1
        for (int t = 0; t < nt; t += 2) {
            const bool last = (t == nt - 2);
            const char* a1 = cA + (size_t)(t + 1) * kstep;
            const char* a2 = last ? nA : cA + (size_t)(t + 2) * kstep; const char* b2 = last ? nB : cB + (size_t)(t + 2) * kstep;
            const char* a3 = a2 + kstep; const char* b3 = b2 + kstep;
            if (last && has_next) S.a_ready(nxt);
            if constexpr (SP2) {
            PG8_LDB(B0, 0, 0); PG8_LDB(B1, 0, 1); PG8_SCHED; PG8_LDA(At, 0, 0); PG8_STAGE(PG8_SA(1, 1), a1 + hstepA, voffA);
            PG8_WAIT_V(8); PG8_WAIT_L(0); PG8_BAR; PG8_MMA(0, 0, At, B0); PG8_MMA(0, 1, At, B1); PG8_BAR; PG8_SCHED;
            PG8_LDA(At, 0, 1); PG8_STAGE(PG8_SB(0, 0), b2, voffB); PG8_STAGE(PG8_SB(0, 1), b2 + hstepB, voffB); PG8_STAGE(PG8_SA(0, 0), a2, voffA);
            PG8_WAIT_V(8); PG8_WAIT_L(0); PG8_BAR; PG8_MMA(1, 0, At, B0); PG8_MMA(1, 1, At, B1); PG8_BAR; PG8_SCHED;
            PG8_LDB(B0, 1, 0); PG8_LDB(B1, 1, 1); PG8_SCHED; PG8_LDA(At, 1, 0); PG8_STAGE(PG8_SA(0, 1), a2 + hstepA, voffA);
            PG8_WAIT_V(8); PG8_WAIT_L(0); PG8_BAR; PG8_MMA(0, 0, At, B0); PG8_MMA(0, 1, At, B1); PG8_BAR; PG8_SCHED;
            PG8_LDA(At, 1, 1); PG8_STAGE(PG8_SB(1, 0), b3, voffB); PG8_STAGE(PG8_SB(1, 1), b3 + hstepB, voffB); PG8_STAGE(PG8_SA(1, 0), a3, voffA);
            PG8_WAIT_V(8); PG8_WAIT_L(0); PG8_BAR; PG8_MMA(1, 0, At, B0); PG8_MMA(1, 1, At, B1); PG8_BAR; PG8_SCHED;
            } else {
            PG8_LDB(B0, 0, 0); PG8_SCHED; PG8_LDA(At, 0, 0); PG8_STAGE(PG8_SA(1, 1), a1 + hstepA, voffA);
            PG8_WAIT_L(8); PG8_BAR; PG8_WAIT_L(0); PG8_MMA(0, 0, At, B0); PG8_BAR; PG8_SCHED;
            PG8_LDB(B1, 0, 1); PG8_STAGE(PG8_SB(0, 0), b2, voffB);
            PG8_BAR; PG8_WAIT_L(0); PG8_MMA(0, 1, At, B1); PG8_BAR;
            PG8_LDA(At, 0, 1); PG8_STAGE(PG8_SA(0, 0), a2, voffA);
            PG8_BAR; PG8_WAIT_L(0); PG8_MMA(1, 0, At, B0); PG8_BAR; PG8_SCHED;
            PG8_STAGE(PG8_SB(0, 1), b2 + hstepB, voffB);
            PG8_WAIT_V(6); PG8_BAR; PG8_MMA(1, 1, At, B1); PG8_BAR;
            PG8_LDB(B0, 1, 0); PG8_SCHED; PG8_LDA(At, 1, 0); PG8_STAGE(PG8_SA(0, 1), a2 + hstepA, voffA);
            PG8_WAIT_L(8); PG8_BAR; PG8_WAIT_L(0); PG8_MMA(0, 0, At, B0); PG8_BAR; PG8_SCHED;
            PG8_LDB(B1, 1, 1); PG8_STAGE(PG8_SB(1, 0), b3, voffB);
            PG8_BAR; PG8_WAIT_L(0); PG8_MMA(0, 1, At, B1); PG8_BAR;
            PG8_LDA(At, 1, 1); PG8_STAGE(PG8_SA(1, 0), a3, voffA);
            PG8_BAR; PG8_WAIT_L(0); PG8_MMA(1, 0, At, B0); PG8_BAR; PG8_SCHED;
            PG8_STAGE(PG8_SB(1, 1), b3 + hstepB, voffB);
            PG8_WAIT_V(6); PG8_BAR; PG8_MMA(1, 1, At, B1); PG8_BAR;
            }
        }
        if constexpr (ALIGN_EPI) { if (wr == 0) PG8_BAR; }
        if constexpr (F8) asm volatile("s_nop 15\n\ts_nop 15" ::: "memory");
        if constexpr (!Epi::AFTER_DRAIN) { E(acc, cur, wr, wc, fr, fq); S.done(cur); }
        if (!has_next) break;
#pragma unroll
        for (int a = 0; a < 2; ++a)
#pragma unroll
            for (int b = 0; b < 2; ++b)
#pragma unroll
                for (int m = 0; m < 4; ++m)
#pragma unroll
                    for (int n = 0; n < 2; ++n) acc[a][b][m][n] = (f32x4){0.f, 0.f, 0.f, 0.f};
        cur = nxt; cA = nA; cB = nB; ++ui;
        if constexpr (ALIGN_EPI) { if (wr == 1) PG8_BAR; }
    }
    PG8_WAIT_V(0);
    if constexpr (!ALIGN_EPI) { if (wr == 0) PG8_BAR; }
    PG8_BAR;
    if constexpr (Epi::AFTER_DRAIN) { E.fused(acc, cur, wr, wc, fr, fq, lds, wid, lane); S.done(cur); }
#undef PG8_SA
#undef PG8_SB
#undef PG8_STAGE
#undef PG8_LDA
#undef PG8_LD16
#undef PG8_LDB16
#undef PG8_MF8
#undef PG8_FBOFF_B0
#undef PG8_FBOFF_B1
#undef PG8_LDB
#undef PG8_MMA
#undef PG8_WAIT_V
#undef PG8_WAIT_L
#undef PG8_BAR
#undef PG8_SCHED
}
}

#include <hip/hip_bf16.h>
#include <cmath>
namespace attn_body {
using bf16=__hip_bfloat16;
using bf16x8=__attribute__((ext_vector_type(8)))short;
using s16x4=__attribute__((ext_vector_type(4)))short;
using f32x16=__attribute__((ext_vector_type(16)))float;
using u32x4=__attribute__((ext_vector_type(4)))unsigned;
constexpr int BATCH=8,NHEAD=4,SEQ=8192,D=64;
constexpr int QP=256,KP=128,VP=2048,OP=1024;
constexpr int NW=8,QBLK=32,QB=QBLK*NW,KVBLK=64,NQB=SEQ/QB;
constexpr int ATTN_UNIT_ROWS=QB;
__device__ __forceinline__ int crow(int r,int hi){return (r&3)+8*(r>>2)+4*hi;}
#define SBAR() __builtin_amdgcn_sched_barrier(0)
__device__ __forceinline__ void cmask(f32x16&p0,f32x16&p1,int jb,int qrel,int hi){
  const float NEG=-INFINITY; int kb=64*jb+4*hi;
  #pragma unroll
  for(int r=0;r<16;++r){int kv=kb+(r&3)+8*(r>>2); if(kv>qrel)p0[r]=NEG; if(kv+32>qrel)p1[r]=NEG;}
}

constexpr int NSLOT=3, SLOTB=8192;
constexpr int LDS_K=0, LDS_V=NSLOT*SLOTB, LDS_WS=2*NSLOT*SLOTB, LDS_OST=LDS_WS+NW*64*4, LDS_BYTES=LDS_OST+NW*4096;
constexpr float C2=0.125f*1.4426950408889634f;
__device__ __forceinline__ void glds16(const void*gsrc,unsigned lds_dst){unsigned keep;
  asm volatile("s_mov_b32 %0, m0\n\ts_mov_b32 m0, %2\n\ts_nop 0\n\tglobal_load_lds_dwordx4 %1, off\n\ts_mov_b32 m0, %0":"=&s"(keep):"v"(gsrc),"s"(lds_dst):"memory");}
__device__ __forceinline__ float max3f(float a,float b,float c){float r;asm("v_max3_f32 %0, %1, %2, %3":"=v"(r):"v"(a),"v"(b),"v"(c));return r;}
__device__ __forceinline__ float max2f(float a,float b){float r;asm("v_max_f32_e32 %0, %1, %2":"=v"(r):"v"(a),"v"(b));return r;}
__device__ __forceinline__ float fadd_s(float a,float b){float r;asm("v_add_f32_e32 %0, %1, %2":"=v"(r):"v"(a),"v"(b));return r;}
__device__ __forceinline__ float fsub_s(float a,float b){float r;asm("v_sub_f32_e32 %0, %1, %2":"=v"(r):"v"(a),"v"(b));return r;}
typedef float f32x2_t __attribute__((ext_vector_type(2))); typedef __bf16 bf16x2_t __attribute__((ext_vector_type(2)));
__device__ __forceinline__ unsigned cvtpk_s(float lo,float hi){f32x2_t v={lo,hi};bf16x2_t b=__builtin_convertvector(v,bf16x2_t);return __builtin_bit_cast(unsigned,b);}
#define WAIT_BAR(N) asm volatile("s_waitcnt vmcnt(" #N ") lgkmcnt(0)\n\ts_barrier":::"memory")

__device__ __forceinline__ void qkt(f32x16&p0,f32x16&p1,const char*Kslot,const bf16x8*qr,const f32x16&negm,int r32,int hi){
  const char*kb=Kslot+hi*1024+r32*16;
  #pragma unroll
  for(int d0=0;d0<4;++d0){
    const bf16x8 b0=*reinterpret_cast<const bf16x8*>(kb+d0*2048);
    const bf16x8 b1=*reinterpret_cast<const bf16x8*>(kb+d0*2048+512);
    if(d0==0){p0=__builtin_amdgcn_mfma_f32_32x32x16_bf16(b0,qr[0],negm,0,0,0);p1=__builtin_amdgcn_mfma_f32_32x32x16_bf16(b1,qr[0],negm,0,0,0);}
    else{p0=__builtin_amdgcn_mfma_f32_32x32x16_bf16(b0,qr[d0],p0,0,0,0);p1=__builtin_amdgcn_mfma_f32_32x32x16_bf16(b1,qr[d0],p1,0,0,0);}}
}
typedef __attribute__((address_space(3))) const char* lds_cptr;
typedef short v4i16_t __attribute__((ext_vector_type(4)));
__device__ __forceinline__ void kload8(bf16x8*kf,lds_cptr kp){
  kf[0]=*(const __attribute__((address_space(3))) bf16x8*)(kp);      kf[1]=*(const __attribute__((address_space(3))) bf16x8*)(kp+512);
  kf[2]=*(const __attribute__((address_space(3))) bf16x8*)(kp+2048); kf[3]=*(const __attribute__((address_space(3))) bf16x8*)(kp+2560);
  kf[4]=*(const __attribute__((address_space(3))) bf16x8*)(kp+4096); kf[5]=*(const __attribute__((address_space(3))) bf16x8*)(kp+4608);
  kf[6]=*(const __attribute__((address_space(3))) bf16x8*)(kp+6144); kf[7]=*(const __attribute__((address_space(3))) bf16x8*)(kp+6656);
}
__device__ __forceinline__ void kload2(bf16x8*kf,lds_cptr kp,int j){ kf[2*j]=*(const __attribute__((address_space(3))) bf16x8*)(kp+j*2048); kf[2*j+1]=*(const __attribute__((address_space(3))) bf16x8*)(kp+j*2048+512); }
__device__ __forceinline__ s16x4 vtr(lds_cptr p){ return __builtin_bit_cast(s16x4,__builtin_amdgcn_ds_read_tr16_b64_v4i16((__attribute__((address_space(3))) v4i16_t*)p)); }
__device__ __forceinline__ float rowmax(const f32x16&p0,const f32x16&p1){
  float a=max3f(p0[0],p0[1],p1[0]),b=max3f(p0[2],p0[3],p1[1]);a=max3f(a,p1[2],p1[3]);
  #pragma unroll
  for(int r=4;r<16;r+=4){a=max3f(a,p0[r],p0[r+1]);b=max3f(b,p0[r+2],p0[r+3]);a=max3f(a,p1[r],p1[r+1]);b=max3f(b,p1[r+2],p1[r+3]);}
  const float m=max2f(a,b);
  auto rr=__builtin_amdgcn_permlane32_swap(__float_as_uint(m),__float_as_uint(m),false,false);
  return max2f(__uint_as_float(rr[0]),__uint_as_float(rr[1]));
}
__device__ __forceinline__ void pv(f32x16*o,int vb,bf16x8 pa0,bf16x8 pa1,bf16x8 pa2,bf16x8 pa3){
  #pragma unroll
  for(int d0=0;d0<2;++d0){s16x4 lo[4],hi[4];
    #pragma unroll
    for(int ks=0;ks<4;++ks){
      asm volatile("ds_read_b64_tr_b16 %0,%1 offset:%c2":"=&v"(lo[ks]):"v"(vb),"i"(d0*4096+ks*1024):"memory");
      asm volatile("ds_read_b64_tr_b16 %0,%1 offset:%c2":"=&v"(hi[ks]):"v"(vb),"i"(d0*4096+ks*1024+512):"memory");}
    asm volatile("s_waitcnt lgkmcnt(0)":::"memory");SBAR();
    #define PK(k) (bf16x8){lo[k][0],lo[k][1],lo[k][2],lo[k][3],hi[k][0],hi[k][1],hi[k][2],hi[k][3]}
    o[d0]=__builtin_amdgcn_mfma_f32_32x32x16_bf16(pa0,PK(0),o[d0],0,0,0);
    o[d0]=__builtin_amdgcn_mfma_f32_32x32x16_bf16(pa1,PK(1),o[d0],0,0,0);
    o[d0]=__builtin_amdgcn_mfma_f32_32x32x16_bf16(pa2,PK(2),o[d0],0,0,0);
    o[d0]=__builtin_amdgcn_mfma_f32_32x32x16_bf16(pa3,PK(3),o[d0],0,0,0);
    #undef PK
  }
}

#ifndef ATTN_STORE16
#define ATTN_STORE16(p,v) (*(u32x4*)(p)=(v))
#endif
template<int THRL> __device__ __forceinline__ void attn_unit(int b,int h,int qb,const bf16*Q,const bf16*__restrict__ K,const bf16*__restrict__ V,bf16*O,char*shm){
  int tid_=threadIdx.x; asm volatile("":"+v"(tid_)); const int tid=tid_,lane=tid&63,r32=lane&31,hi=lane>>5; const int wid=__builtin_amdgcn_readfirstlane(tid>>6);
  const long rowbase=(long)b*SEQ; const int q0=qb*QB;
  const bf16*Qw=Q+(rowbase+q0+wid*QBLK)*QP+h*D;
  const bf16*Kh=K+rowbase*KP+(h>>1)*D,*Vh=V+rowbase*VP+(h>>1)*D;
  const unsigned lds0=(unsigned)(uintptr_t)shm;
  float*wsf=(float*)(shm+LDS_WS)+wid*64;
  const bf16*ksrc=Kh+(long)lane*KP+wid*8;
  const bf16*vsrc=Vh+(long)(16*(wid&3)+(lane>>2))*VP+(wid>>2)*32+(lane&3)*8;
  const unsigned kdst=lds0+LDS_K+wid*1024, vdst=lds0+LDS_V+wid*1024;
  #define DMA_K(t,slot) glds16(ksrc+(long)(t)*KVBLK*KP,(unsigned)__builtin_amdgcn_readfirstlane(kdst+(slot)))
  #define DMA_V(t,slot) glds16(vsrc+(long)(t)*KVBLK*VP,(unsigned)__builtin_amdgcn_readfirstlane(vdst+(slot)))
  const int vb0=(int)(lds0+LDS_V)+((lane>>4)&1)*32+(lane&3)*8+(4*hi+((lane&15)>>2))*64;
  const char*Kbase=shm+LDS_K; bf16x8 kf[8];
  const lds_cptr shm3=(lds_cptr)shm; const lds_cptr kp0=shm3+LDS_K+hi*1024+r32*16; const lds_cptr vp0=shm3+LDS_V+((lane>>4)&1)*32+(lane&3)*8+(4*hi+((lane&15)>>2))*64;
  const int NT=SEQ/KVBLK;
  DMA_K(0,0);DMA_V(0,0);DMA_K(1,SLOTB);
  bf16x8 qr[4];
  #pragma unroll
  for(int d0=0;d0<4;++d0)qr[d0]=*reinterpret_cast<const bf16x8*>(&Qw[(long)r32*QP+d0*16+hi*8]);
  float mhat=0.f,l_reg=0.f;f32x16 o[2];o[0]=f32x16{};o[1]=f32x16{};f32x16 negm=f32x16{};asm volatile("":"+v"(negm));
  #define CMASK(P0,P1,t) do{}while(0)
  bool resc=false;
  #define START(P0,P1) do{ const float rm=rowmax(P0,P1); resc=false; \
    { const float dl=rm; mhat=fadd_s(mhat,dl); \
      _Pragma("unroll") for(int r=0;r<16;++r){P0[r]=fsub_s(P0[r],dl);P1[r]=fsub_s(P1[r],dl);} \
      _Pragma("unroll") for(int r=0;r<16;++r)negm[r]=-mhat; asm volatile("":"+v"(negm)); } \
    _Pragma("unroll") for(int r=0;r<16;++r)P0[r]=__builtin_amdgcn_exp2f(P0[r]); }while(0)
  #define RESC() do{ if(resc){ asm volatile("s_waitcnt lgkmcnt(0)":::"memory"); \
      _Pragma("unroll") for(int d_=0;d_<2;++d_) _Pragma("unroll") for(int r=0;r<16;++r)o[d_][r]*=wsf[crow(r,hi)]; } }while(0)
  f32x16 pA0,pA1,pB0,pB1;
  int sl_prev=0,sl_cur=0,sl_next=SLOTB;
  #define ROT() do{sl_prev=sl_cur;sl_cur=sl_next;sl_next=(sl_next==(NSLOT-1)*SLOTB)?0:sl_next+SLOTB;}while(0)
  DMA_K(2,2*SLOTB);
  WAIT_BAR(3);
  qkt(pA0,pA1,Kbase,qr,negm,r32,hi);asm volatile("s_nop 15\n\ts_nop 7":"+v"(pA0),"+v"(pA1));CMASK(pA0,pA1,0);
  START(pA0,pA1);
  _Pragma("unroll") for(int r=0;r<16;++r)pA1[r]=__builtin_amdgcn_exp2f(pA1[r]);
  WAIT_BAR(0);
  DMA_K(3,0);DMA_V(1,SLOTB);
  ROT();
  kload8(kf,kp0+sl_cur);
  WAIT_BAR(2);
  s16x4 vlo[8],vhi[8]; u32x4 pw0,pw1,pw2,pw3;
  #define PKW(P,B) cvtpk_s(P[B],P[B+1])
  #define PAF(k) __builtin_bit_cast(bf16x8,pw##k)
  #define VFR(i) (bf16x8){vlo[i][0],vlo[i][1],vlo[i][2],vlo[i][3],vhi[i][0],vhi[i][1],vhi[i][2],vhi[i][3]}
  #define PIN(x) asm volatile("":"+v"(x))
  #define MX3(a,b,c) __builtin_fmaxf(__builtin_fmaxf((a),(b)),(c))
  #define GAPA(MF,A0,A1,A2,A3,W0,W1,PW) do{ MF; sacc+=A0; sacc+=A1; sacc+=A2; sacc+=A3; PIN(sacc); W0; W1; PIN(PW); SBAR(); }while(0)
  #define EX(v) __builtin_amdgcn_exp2f(v)
  #define GAPB(MF,X,B) do{ MF; X[B]=EX(X[B]); X[B+1]=EX(X[B+1]); X[B+2]=EX(X[B+2]); X[B+3]=EX(X[B+3]); PIN(X); SBAR(); }while(0)
  #define VRD(i) do{ vlo[i]=vtr(vp_+(((i)>>2)*4096+((i)&3)*1024)); vhi[i]=vtr(vp_+(((i)>>2)*4096+((i)&3)*1024+512)); }while(0)
  #define KRD(G,j) do{ if(G){ kload2(kf,kp0+sl_next,j); SBAR(); } }while(0)
  #define STEP(C0,C1,P0,P1,t,GK,GV,GL) do{ SBAR(); \
    const lds_cptr vp_=vp0+sl_prev; \
    VRD(0); SBAR(); float sacc=(P0[0]+P0[1]); \
    GAPA(C0=__builtin_amdgcn_mfma_f32_32x32x16_bf16(kf[0],qr[0],negm,0,0,0), P0[2],P0[3],P0[4],P0[5],     pw0[0]=PKW(P0,0), pw0[1]=PKW(P0,2), pw0); \
    VRD(4); SBAR(); GAPA(C1=__builtin_amdgcn_mfma_f32_32x32x16_bf16(kf[1],qr[0],negm,0,0,0), P0[6],P0[7],P0[8],P0[9],     pw0[2]=PKW(P0,4), pw0[3]=PKW(P0,6), pw0); \
    VRD(1); SBAR(); GAPA(C0=__builtin_amdgcn_mfma_f32_32x32x16_bf16(kf[2],qr[1],C0,0,0,0),   P0[10],P0[11],P0[12],P0[13], pw1[0]=PKW(P0,8), pw1[1]=PKW(P0,10), pw1); \
    VRD(5); SBAR(); GAPA(C1=__builtin_amdgcn_mfma_f32_32x32x16_bf16(kf[3],qr[1],C1,0,0,0),   P0[14],P0[15],P1[0],P1[1],   pw1[2]=PKW(P0,12),pw1[3]=PKW(P0,14), pw1); \
    VRD(2); SBAR(); GAPA(C0=__builtin_amdgcn_mfma_f32_32x32x16_bf16(kf[4],qr[2],C0,0,0,0),   P1[2],P1[3],P1[4],P1[5],     pw2[0]=PKW(P1,0), pw2[1]=PKW(P1,2), pw2); \
    VRD(6); SBAR(); GAPA(C1=__builtin_amdgcn_mfma_f32_32x32x16_bf16(kf[5],qr[2],C1,0,0,0),   P1[6],P1[7],P1[8],P1[9],     pw2[2]=PKW(P1,4), pw2[3]=PKW(P1,6), pw2); \
    VRD(3); SBAR(); GAPA(C0=__builtin_amdgcn_mfma_f32_32x32x16_bf16(kf[6],qr[3],C0,0,0,0),   P1[10],P1[11],P1[12],P1[13], pw3[0]=PKW(P1,8), pw3[1]=PKW(P1,10), pw3); \
    VRD(7); SBAR(); GAPA(C1=__builtin_amdgcn_mfma_f32_32x32x16_bf16(kf[7],qr[3],C1,0,0,0),   P1[14],P1[15],0.f,0.f,       pw3[2]=PKW(P1,12),pw3[3]=PKW(P1,14), pw3); \
    l_reg+=sacc; \
    if(GK){DMA_K((t)+3,sl_cur);} if(GV){DMA_V((t)+1,sl_next);} \
    CMASK(C0,C1,t); \
    { float a=MX3(C0[0],C0[1],C1[0]),b=MX3(C0[2],C0[3],C1[1]); a=MX3(a,C1[2],C1[3]); \
      _Pragma("unroll") for(int r=4;r<16;r+=4){a=MX3(a,C0[r],C0[r+1]);b=MX3(b,C0[r+2],C0[r+3]);a=MX3(a,C1[r],C1[r+1]);b=MX3(b,C1[r+2],C1[r+3]);} \
      float rm=__builtin_fmaxf(a,b); { auto rr=__builtin_amdgcn_permlane32_swap(__float_as_uint(rm),__float_as_uint(rm),false,false); rm=__builtin_fmaxf(__uint_as_float(rr[0]),__uint_as_float(rr[1])); } \
      resc=false; \
      if(__builtin_expect(__any(rm>(float)THRL),0)){ const float dl=__builtin_fmaxf(rm,0.f); mhat+=dl; \
        _Pragma("unroll") for(int r=0;r<16;++r){C0[r]-=dl;C1[r]-=dl;} \
        _Pragma("unroll") for(int r=0;r<16;++r)negm[r]=-mhat; asm volatile("":"+v"(negm)); \
        const float f=__builtin_amdgcn_exp2f(-dl); l_reg*=f; if(hi==0)wsf[r32]=f; resc=true; } } \
    SBAR(); \
    GAPB(o[0]=__builtin_amdgcn_mfma_f32_32x32x16_bf16(PAF(0),VFR(0),o[0],0,0,0), C0,0); \
    GAPB(o[1]=__builtin_amdgcn_mfma_f32_32x32x16_bf16(PAF(0),VFR(4),o[1],0,0,0), C0,4); \
    KRD(GL,0); GAPB(o[0]=__builtin_amdgcn_mfma_f32_32x32x16_bf16(PAF(1),VFR(1),o[0],0,0,0), C0,8); \
    KRD(GL,1); GAPB(o[1]=__builtin_amdgcn_mfma_f32_32x32x16_bf16(PAF(1),VFR(5),o[1],0,0,0), C0,12); \
    KRD(GL,2); GAPB(o[0]=__builtin_amdgcn_mfma_f32_32x32x16_bf16(PAF(2),VFR(2),o[0],0,0,0), C1,0); \
    KRD(GL,3); GAPB(o[1]=__builtin_amdgcn_mfma_f32_32x32x16_bf16(PAF(2),VFR(6),o[1],0,0,0), C1,4); \
    GAPB(o[0]=__builtin_amdgcn_mfma_f32_32x32x16_bf16(PAF(3),VFR(3),o[0],0,0,0), C1,8); \
    GAPB(o[1]=__builtin_amdgcn_mfma_f32_32x32x16_bf16(PAF(3),VFR(7),o[1],0,0,0), C1,12); \
    }while(0)
  int t=1;
  #undef CMASK
  #define CMASK(P0,P1,t) do{}while(0)
  for(;t+5<NT;t+=2){
    STEP(pB0,pB1,pA0,pA1,t,true,true,true);     WAIT_BAR(2); RESC(); ROT();
    STEP(pA0,pA1,pB0,pB1,t+1,true,true,true);   WAIT_BAR(2); RESC(); ROT();
  }
  #undef CMASK
  #define CMASK(P0,P1,t) do{}while(0)
  #define ENDW(tt) do{ if((tt)+3<NT){WAIT_BAR(2);} else if((tt)+2<NT){WAIT_BAR(1);} else {WAIT_BAR(0);} }while(0)
  for(;t+1<NT;t+=2){
    STEP(pB0,pB1,pA0,pA1,t,(t+3<NT),(t+1<NT),(t+1<NT));       ENDW(t);   RESC(); ROT();
    STEP(pA0,pA1,pB0,pB1,t+1,(t+4<NT),(t+2<NT),(t+2<NT));     ENDW(t+1); RESC(); ROT();
  }
  STEP(pB0,pB1,pA0,pA1,NT-1,false,false,false); RESC();
  { float sacc=pB0[0]+pB0[1]; _Pragma("unroll") for(int r=2;r<16;++r)sacc+=pB0[r]; _Pragma("unroll") for(int r=0;r<16;++r)sacc+=pB1[r]; l_reg+=sacc;
    pw0=(u32x4){PKW(pB0,0),PKW(pB0,2),PKW(pB0,4),PKW(pB0,6)};pw1=(u32x4){PKW(pB0,8),PKW(pB0,10),PKW(pB0,12),PKW(pB0,14)};pw2=(u32x4){PKW(pB1,0),PKW(pB1,2),PKW(pB1,4),PKW(pB1,6)};pw3=(u32x4){PKW(pB1,8),PKW(pB1,10),PKW(pB1,12),PKW(pB1,14)};
    SBAR(); pv(o,vb0+sl_cur,PAF(0),PAF(1),PAF(2),PAF(3)); }
  #undef PKW
  #undef PAF
  #undef VFR
  #undef PIN
  #undef MX3
  #undef GAPA
  #undef GAPB
  #undef EX
  #undef VRD
  #undef KRD
  #undef STEP
  #undef ENDW
  {auto rr=__builtin_amdgcn_permlane32_swap(__float_as_uint(l_reg),__float_as_uint(l_reg),false,false);l_reg=__uint_as_float(rr[0])+__uint_as_float(rr[1]);}
  if(hi==0)wsf[32+r32]=l_reg;asm volatile("s_waitcnt lgkmcnt(0)":::"memory");
  float rli[16];
  #pragma unroll
  for(int r=0;r<16;++r)rli[r]=__builtin_amdgcn_rcpf(wsf[32+crow(r,hi)]);
  bf16*Ow=O+(rowbase+q0+wid*QBLK)*OP+h*D;
  { bf16*stg=(bf16*)(shm+LDS_OST)+wid*2048;
    #pragma unroll
    for(int r=0;r<16;++r){const int orow=crow(r,hi);
      #pragma unroll
      for(int d0=0;d0<2;++d0)stg[orow*64+d0*32+r32]=__float2bfloat16(o[d0][r]*rli[r]);}
    asm volatile("s_waitcnt lgkmcnt(0)":::"memory");
    #pragma unroll
    for(int i=0;i<4;++i){const int row=i*8+(lane>>3),ch=lane&7; const u32x4 v=*(const u32x4*)(stg+row*64+ch*8); ATTN_STORE16(Ow+(long)row*OP+ch*8,v);} }
  asm volatile("s_waitcnt lgkmcnt(0)\n\ts_barrier":::"memory");
  #undef DMA_K
  #undef DMA_V
  #undef CMASK
  #undef START
  #undef RESC
  #undef ROT
}
constexpr int ATTN_LDS_BYTES=LDS_BYTES;
struct AttnTensors { const bf16* Q; const bf16* K; const bf16* V; bf16* O; };
struct AttnUnit { int b; int h; int qb; };
struct StaticOrder {
  int vcu;
  __device__ __forceinline__ explicit StaticOrder(int vcu_):vcu(vcu_){}
  __device__ __forceinline__ bool next(int i,AttnUnit&u)const{ if(i>=4)return false; const int x=vcu>>5,j=vcu&31,grp=2*x+(i>>1); u.b=grp>>1; u.h=(grp&1)*2+(i&1); u.qb=j; return true; }
  __device__ __forceinline__ void a_ready(const AttnUnit&)const{}
  __device__ __forceinline__ void done(const AttnUnit&)const{}
};
template<class Sched,int THRL=8> __device__ __forceinline__ void attn_phase(char*lds,const AttnTensors&T,const Sched&S){
  AttnUnit u;
  for(int i=0;S.next(i,u);++i){ S.a_ready(u); attn_unit<THRL>(u.b,u.h,u.qb,T.Q,T.K,T.V,T.O,lds); S.done(u); }
}
#undef SBAR
#undef WAIT_BAR
}

#define GAS __attribute__((address_space(1)))
#define LAS __attribute__((address_space(3)))
typedef unsigned short bf16;
typedef unsigned v4u __attribute__((ext_vector_type(4)));
typedef float f32x4 __attribute__((ext_vector_type(4)));
typedef short bf16x8 __attribute__((ext_vector_type(8)));
typedef GAS unsigned gu32;
typedef GAS unsigned long long gu64;
#define RLX_AGENT __ATOMIC_RELAXED, __HIP_MEMORY_SCOPE_AGENT
#define LDS_WAIT() asm volatile("s_waitcnt lgkmcnt(0)" ::: "memory")
#define VM_WAIT() asm volatile("s_waitcnt vmcnt(0)" ::: "memory")
__device__ __forceinline__ unsigned long long rt() { return __builtin_amdgcn_s_memrealtime(); }
__device__ __forceinline__ unsigned f2bf(float f) { unsigned u = __builtin_bit_cast(unsigned, f); return (u + 0x7fffu + ((u >> 16) & 1u)) >> 16; }
__device__ __forceinline__ unsigned pk2(float lo, float hi) { return f2bf(lo) | (f2bf(hi) << 16); }

#define XB_TMO      128
#define XB_XCNT(j)  (256  + 64 * (j))
#define XB_XSUB(j)  (1280 + 64 * (j))
#define XB_XGEN(j)  (2304 + 64 * (j))
#define XB_TOP      3328
#define XB_TOPGEN   3392
#define XCD_BAR_WORDS 3456
#define XB_SPIN_CAP (1u << 18)

__device__ __forceinline__ unsigned xb_ld(unsigned* p)              { return __hip_atomic_load(p, __ATOMIC_RELAXED, __HIP_MEMORY_SCOPE_AGENT); }
__device__ __forceinline__ unsigned xb_add(unsigned* p, unsigned v) { return __hip_atomic_fetch_add(p, v, __ATOMIC_RELAXED, __HIP_MEMORY_SCOPE_AGENT); }
__device__ __forceinline__ unsigned xb_xcc_id() { return (unsigned)__builtin_amdgcn_s_getreg((3 << 11) | 20) & 0xFu; }
#define XB_SPIN(cond, bar) do { unsigned _sp = 0; while (cond) { __builtin_amdgcn_s_sleep(1); \
    if ((++_sp & 255u) == 0u) { if (xb_ld(&(bar)[XB_TMO])) break; if (_sp > XB_SPIN_CAP) { atomicAdd(&(bar)[XB_TMO], 1u); break; } } } } while (0)

struct XcdBarrier {
    unsigned* bar; unsigned x;
    volatile LAS unsigned* st;
};

__device__ __forceinline__ XcdBarrier xcd_barrier_post(unsigned* bar, volatile LAS unsigned* st) {
    XcdBarrier b; b.bar = bar; b.x = xb_xcc_id(); b.st = st;
    if (threadIdx.x == 0) (void)xb_add(&bar[XB_XCNT(b.x)], 1u);
    return b;
}
__device__ __forceinline__ void xcd_barrier_complete(unsigned* bar, unsigned x, unsigned& nloc, unsigned& nx) {
    const unsigned G = gridDim.x * gridDim.y * gridDim.z;
    unsigned sum, cnt, mine, sp = 0u;
    for (;;) {
        sum = 0u; cnt = 0u; mine = 0u;
#pragma unroll
        for (unsigned j = 0; j < 16; ++j) { const unsigned c = xb_ld(&bar[XB_XCNT(j)]); sum += c; cnt += (c > 0u) ? 1u : 0u; mine = (j == x) ? c : mine; }
        if (sum == G) break;
        __builtin_amdgcn_s_sleep(1);
        if ((++sp & 255u) == 0u) { if (xb_ld(&bar[XB_TMO])) break; if (sp > XB_SPIN_CAP) { atomicAdd(&bar[XB_TMO], 1u); break; } }
    }
    nloc = mine > 0u ? mine : 1u; nx = cnt > 0u ? cnt : 1u;
}

__device__ __forceinline__ void xcd_barrier(const XcdBarrier& b) {
    asm volatile("s_waitcnt vmcnt(0)" ::: "memory");
    __syncthreads();
    if (threadIdx.x == 0) {
        unsigned* bar = b.bar;
        __builtin_amdgcn_s_waitcnt(0);
        unsigned nloc = b.st[0], nx = b.st[1];
        if (nloc == 0u) { xcd_barrier_complete(bar, b.x, nloc, nx); b.st[0] = nloc; b.st[1] = nx; }
        const unsigned old = xb_add(&bar[XB_XSUB(b.x)], 1u);
        const unsigned gen = old / nloc;
        if (old + 1u == (gen + 1u) * nloc) {
            __builtin_amdgcn_fence(__ATOMIC_RELEASE, "agent");
            asm volatile("s_waitcnt vmcnt(0)" ::: "memory");
            const unsigned og = xb_add(&bar[XB_TOP], 1u);
            const unsigned tg = og / nx;
            if (og + 1u == (tg + 1u) * nx) xb_add(&bar[XB_TOPGEN], 1u);
            else XB_SPIN(xb_ld(&bar[XB_TOPGEN]) == tg, bar);
            __builtin_amdgcn_fence(__ATOMIC_ACQUIRE, "agent");
            xb_add(&bar[XB_XGEN(b.x)], 1u);
            asm volatile("s_waitcnt vmcnt(0)" ::: "memory");
        } else {
            XB_SPIN(xb_ld(&bar[XB_XGEN(b.x)]) == gen, bar);
            __builtin_amdgcn_fence(__ATOMIC_ACQUIRE, "agent");
            asm volatile("s_waitcnt vmcnt(0)" ::: "memory");
        }
    }
    __syncthreads();
}


namespace pg8 {
__device__ __forceinline__ float bflo(unsigned w) { return __uint_as_float(w << 16); }
__device__ __forceinline__ float bfhi(unsigned w) { return __uint_as_float(w & 0xffff0000u); }
__device__ __forceinline__ float sigm(float z) { return __builtin_amdgcn_rcpf(1.0f + __builtin_amdgcn_exp2f(-1.4426950408889634f * z)); }
typedef unsigned u32x2 __attribute__((ext_vector_type(2)));
__device__ __forceinline__ unsigned pk4_fp8(float a, float b, float c, float d) { int w = __builtin_amdgcn_cvt_pk_fp8_f32(a, b, 0, false); w = __builtin_amdgcn_cvt_pk_fp8_f32(c, d, w, true); return (unsigned)w; }
constexpr float W1_SCALE = 64.f, W2_SCALE = 128.f;

struct BranchOrder : StaticOrder {
    __device__ bool next(int i, Unit& u) const { if (!StaticOrder::next(i, u)) return false; u.ka = (u.pn >> 2) * 256; return true; }
};
struct EpiGate {
    static constexpr bool PERM = false, AFTER_DRAIN = false;
    const bf16_t* P; const float* bg; bf16_t* O;
    __device__ __forceinline__ void operator()(const f32x4 (&acc)[2][2][4][2], const Unit& u, int wr, int wc, int fr, int fq) const {
        const int d0 = u.pn * 64 + 16 * wc + 4 * fq;
        f32x4 bv[2][2];
#pragma unroll
        for (int bj = 0; bj < 2; ++bj)
#pragma unroll
            for (int n = 0; n < 2; ++n) bv[bj][n] = *(const f32x4*)(bg + (2 * bj + n) * 1024 + d0);
#pragma unroll
        for (int ai = 0; ai < 2; ++ai)
#pragma unroll
            for (int m = 0; m < 4; ++m) { const size_t row = (size_t)(u.pm * BM + ai * HALF + wr * 64 + m * 16 + fr); const bf16_t* prow = P + row * 4096 + d0;
                f32x4 s = (f32x4){0.f, 0.f, 0.f, 0.f};
#pragma unroll
                for (int bj = 0; bj < 2; ++bj)
#pragma unroll
                    for (int n = 0; n < 2; ++n) { const u32x2 pw = *(const u32x2*)(prow + (2 * bj + n) * 1024); const f32x4 z = acc[ai][bj][m][n] + bv[bj][n];
                        s[0] += sigm(z[0]) * bflo(pw.x); s[1] += sigm(z[1]) * bfhi(pw.x); s[2] += sigm(z[2]) * bflo(pw.y); s[3] += sigm(z[3]) * bfhi(pw.y); }
                u32x2 w; w.x = cvt_pk_bf16(s[0], s[1]); w.y = cvt_pk_bf16(s[2], s[3]); *(u32x2*)(O + row * 1024 + d0) = w; }
    }
};
struct EpiResid {
    static constexpr bool PERM = false, AFTER_DRAIN = false;
    const float* H; float* Y; float alpha;
    __device__ __forceinline__ void operator()(const f32x4 (&acc)[2][2][4][2], const Unit& u, int wr, int wc, int fr, int fq) const {
        const int row0 = u.pm * BM + wr * 64 + fr, col0 = u.pn * BM + wc * 32 + 4 * fq;
#pragma unroll
        for (int ai = 0; ai < 2; ++ai)
#pragma unroll
            for (int m = 0; m < 4; ++m) { const size_t ro = (size_t)(row0 + ai * HALF + m * 16) * 1024 + col0;
#pragma unroll
                for (int bj = 0; bj < 2; ++bj)
#pragma unroll
                    for (int n = 0; n < 2; ++n) { const f32x4 h = *(const f32x4*)(H + ro + bj * HALF + n * 16); *(f32x4*)(Y + ro + bj * HALF + n * 16) = h * alpha + acc[ai][bj][m][n]; } }
    }
};
struct EpiSwiglu {
    static constexpr bool PERM = true, AFTER_DRAIN = false;
    unsigned char* O; const float* bgu;
    __device__ __forceinline__ void operator()(const f32x4 (&acc)[2][2][4][2], const Unit& u, int wr, int wc, int fr, int fq) const {
        const int e = u.pn >> 3, ct = u.pn & 7, cc0 = ct * 128 + wc * 32 + 8 * fq;
        const float* bb = bgu + e * 2048 + cc0;
        f32x4 bg[2], bl[2];
#pragma unroll
        for (int n = 0; n < 2; ++n) { bg[n] = *(const f32x4*)(bb + 4 * n); bl[n] = *(const f32x4*)(bb + 1024 + 4 * n); }
#pragma unroll
        for (int ai = 0; ai < 2; ++ai)
#pragma unroll
            for (int m = 0; m < 4; ++m) { const size_t row = (size_t)(u.pm * BM + ai * HALF + wr * 64 + m * 16 + fr);
                float o[8];
#pragma unroll
                for (int n = 0; n < 2; ++n)
#pragma unroll
                    for (int j = 0; j < 4; ++j) { float gl = acc[ai][0][m][n][j] * (1.f / W1_SCALE) + bg[n][j], li = acc[ai][1][m][n][j] * (1.f / W1_SCALE) + bl[n][j];
                        gl = fminf(gl, 7.0f); li = fminf(fmaxf(li, -7.0f), 7.0f); o[4 * n + j] = gl * sigm(1.702f * gl) * (li + 1.0f); }
                u32x2 w; w.x = pk4_fp8(o[0], o[1], o[2], o[3]); w.y = pk4_fp8(o[4], o[5], o[6], o[7]);
                *(u32x2*)(O + row * 1024 + cc0) = w; }
    }
};
struct EpiDown {
    static constexpr bool PERM = true, AFTER_DRAIN = false;
    bf16_t* O; const float* bd;
    __device__ __forceinline__ void operator()(const f32x4 (&acc)[2][2][4][2], const Unit& u, int wr, int wc, int fr, int fq) const {
        const int e = u.pn >> 2, ct = u.pn & 3, col0 = ct * 256 + wc * 32 + 8 * fq;
        const float* bb = bd + e * 1024 + col0;
        f32x4 bv[2][2];
#pragma unroll
        for (int bj = 0; bj < 2; ++bj)
#pragma unroll
            for (int n = 0; n < 2; ++n) bv[bj][n] = *(const f32x4*)(bb + bj * HALF + 4 * n);
#pragma unroll
        for (int ai = 0; ai < 2; ++ai)
#pragma unroll
            for (int m = 0; m < 4; ++m) { bf16_t* rowp = O + (size_t)(u.pm * BM + ai * HALF + wr * 64 + m * 16 + fr) * 1024 + col0;
#pragma unroll
                for (int bj = 0; bj < 2; ++bj) { const f32x4 v0 = acc[ai][bj][m][0] * (1.f / W2_SCALE) + bv[bj][0], v1 = acc[ai][bj][m][1] * (1.f / W2_SCALE) + bv[bj][1];
                    u32x4 w; w.x = cvt_pk_bf16(v0[0], v0[1]); w.y = cvt_pk_bf16(v0[2], v0[3]); w.z = cvt_pk_bf16(v1[0], v1[1]); w.w = cvt_pk_bf16(v1[2], v1[3]);
                    *(u32x4*)(rowp + bj * HALF) = w; } }
    }
};
struct MoeOrder {
    const PG8_LAS int* tab; int nct, G, c;
    __device__ bool next(int i, Unit& u) const {
        const int L = i * G + c; if (L >= tab[32]) return false;
        int e = 0;
#pragma unroll 1
        while (e < 31 && L >= tab[e + 1]) ++e;
        const int r = L - tab[e], nt = (tab[e + 1] - tab[e]) / nct, nig = 8 * nct, gid = r / nig, fm = gid * 8, gsz = (nt - fm) < 8 ? (nt - fm) : 8, rr = r % nig;
        u.pm = tab[33 + e] + fm + (rr % gsz); u.pn = e * nct + rr / gsz; u.ka = 0; return true;
    }
    __device__ __forceinline__ void a_ready(const Unit&) const {}
    __device__ __forceinline__ void done(const Unit&) const {}
};
}

constexpr int NWAVES = 8;
#ifndef MK_ONE_LAUNCH
#define MK_ONE_LAUNCH 1
#endif
#ifndef REP_MASK
#define REP_MASK 0
#endif
constexpr int NB = 8, SEQ = 8192, D = 1024, M = NB * SEQ, DEPTH = 2;
constexpr int IN_COLS = 6144, ZSW = 2048;
constexpr int NE = 32, TOPK = 4, RMAX = M * TOPK + NE * 256;
constexpr float DN_ALPHA = 1.4142135623730951f, LN_EPS = 1e-5f, RMS_EPS = 1e-6f;
constexpr float QSCALE = 0.125f * 1.4426950408889634f;
constexpr int NSUB = 11, NPH = 1 + DEPTH * NSUB;
constexpr size_t MiB = 1u << 20;
constexpr size_t WS_CTL = 0, CTL_ZERO_BYTES = 1 * MiB;
constexpr size_t WS_TOPE = 1 * MiB, WS_TOPW = 2 * MiB, WS_TOPR = 3 * MiB, WS_WGB = 4 * MiB, WS_ROPE = 5 * MiB, WS_TOPP = 6 * MiB;
constexpr size_t WS_W0 = 8 * MiB, W_LAYER = 208 * MiB;
constexpr size_t WO_INS = 0, WO_G = 4 * MiB, WO_B = 12 * MiB, WO_O = 14 * MiB, WO_GU = 16 * MiB, WO_D = 144 * MiB;
constexpr size_t WS_HB = WS_W0 + 2 * W_LAYER;
constexpr size_t WS_OV = WS_HB + 128 * MiB;
constexpr size_t WS_ZS = WS_OV, WS_QN = WS_OV + 256 * MiB, WS_KN = WS_OV + 288 * MiB, WS_BR = WS_OV + 304 * MiB, WS_MG = WS_OV + 432 * MiB, WS_P = WS_OV + 560 * MiB;
constexpr size_t WS_XS = WS_OV + 528 * MiB, WS_Y = WS_OV, WS_HA = WS_OV + 792 * MiB;
constexpr size_t WS_Y1 = WS_OV + 1072 * MiB;
constexpr size_t WS_H1 = WS_Y1;
constexpr size_t WS_X8 = WS_Y1 + 256 * MiB;
constexpr size_t WS_END = WS_X8 + 64 * MiB;
static_assert((size_t)RMAX * 1024 * 2 <= 528 * MiB, "MoE row buffers");
constexpr int CW_TMO = 0, CW_CODE = 1, CW_BAR = 4096, CW_CNT = 8192;
constexpr int RING_OFF = 0, RING_BYTES = 131072;
constexpr int LDSCTL_OFF = RING_BYTES, MISC_OFF = LDSCTL_OFF + 320;
constexpr int TAB_OFF = LDSCTL_OFF + 1024;
constexpr int HIST_OFF = TAB_OFF + 512, LG_OFF = TAB_OFF + 1024;
constexpr int LDS_BYTES = 147456;

struct Args { const float* in[26]; float* out; unsigned char* ws; int ph_lo, ph_hi; };
typedef const __attribute__((address_space(4))) Args* CArgs;
struct Frame { LAS unsigned char* lds; volatile LAS unsigned* MISC; gu32* ctl; int tid, lane, wave, vcu, G, wg; };

using pg8::bflo; using pg8::bfhi; using pg8::sigm; using pg8::cvt_pk_bf16;
typedef unsigned v2u __attribute__((ext_vector_type(2)));
__device__ __forceinline__ float wave_sum(float v) {
#pragma unroll
    for (int o = 1; o < 64; o <<= 1) v += __shfl_xor(v, o);
    return v;
}
__device__ __forceinline__ void unpack8(const v4u v, float (&x)[8]) { x[0] = bflo(v.x); x[1] = bfhi(v.x); x[2] = bflo(v.y); x[3] = bfhi(v.y); x[4] = bflo(v.z); x[5] = bfhi(v.z); x[6] = bflo(v.w); x[7] = bfhi(v.w); }
__device__ __forceinline__ v4u pack8(const float (&x)[8]) { v4u o; o.x = cvt_pk_bf16(x[0], x[1]); o.y = cvt_pk_bf16(x[2], x[3]); o.z = cvt_pk_bf16(x[4], x[5]); o.w = cvt_pk_bf16(x[6], x[7]); return o; }

struct RmId { __device__ __forceinline__ int operator()(int n) const { return n; } };
struct RmGate { __device__ __forceinline__ int operator()(int n) const { const int g = n >> 10, d = n & 1023, pn = d >> 6, dl = d & 63; return 256 * pn + 128 * (g >> 1) + 32 * (dl >> 4) + 16 * (g & 1) + (dl & 15); } };
struct RmGlu { __device__ __forceinline__ int operator()(int n) const { const int j = n & 1023, lin = n >> 10; return 256 * (j >> 7) + 128 * lin + (j & 127); } };
template <class RM>
__device__ __forceinline__ void transpose_item(const float* W, int ldw, bf16* WT, int ldt, const RM rm, LAS float* scr, int kb, int nb, int lane) {
    const int k0 = 64 * kb, n0 = 32 * nb;
#pragma unroll
    for (int i = 0; i < 32; ++i) { const int kk = 2 * i + (lane >> 5); scr[kk * 33 + (lane & 31)] = W[(size_t)(k0 + kk) * ldw + n0 + (lane & 31)]; }
    LDS_WAIT(); asm volatile("" ::: "memory");
    const int c = lane & 7;
#pragma unroll
    for (int j = 0; j < 4; ++j) { const int n = (lane >> 3) + 8 * j; const LAS float* s = scr + (8 * c) * 33 + n;
        v4u o; o.x = cvt_pk_bf16(s[0 * 33], s[1 * 33]); o.y = cvt_pk_bf16(s[2 * 33], s[3 * 33]); o.z = cvt_pk_bf16(s[4 * 33], s[5 * 33]); o.w = cvt_pk_bf16(s[6 * 33], s[7 * 33]);
        *(GAS v4u*)(WT + (size_t)rm(n0 + n) * ldt + k0 + 8 * c) = o; }
    LDS_WAIT(); asm volatile("" ::: "memory");
}
template <class RM>
__device__ __forceinline__ void transpose_item8(const float* W, int ldw, unsigned char* WT, int ldt, const RM rm, LAS float* scr, int kb, int nb, int lane, float scale) {
    const int k0 = 64 * kb, n0 = 32 * nb;
#pragma unroll
    for (int i = 0; i < 32; ++i) { const int kk = 2 * i + (lane >> 5); scr[kk * 33 + (lane & 31)] = W[(size_t)(k0 + kk) * ldw + n0 + (lane & 31)] * scale; }
    LDS_WAIT(); asm volatile("" ::: "memory");
    const int c = lane & 7;
#pragma unroll
    for (int j = 0; j < 4; ++j) { const int n = (lane >> 3) + 8 * j; const LAS float* s = scr + (8 * c) * 33 + n;
        v2u o; o.x = pg8::pk4_fp8(s[0 * 33], s[1 * 33], s[2 * 33], s[3 * 33]); o.y = pg8::pk4_fp8(s[4 * 33], s[5 * 33], s[6 * 33], s[7 * 33]);
        *(GAS v2u*)(WT + (size_t)rm(n0 + n) * ldt + k0 + 8 * c) = o; }
    LDS_WAIT(); asm volatile("" ::: "memory");
}
__device__ __forceinline__ void ln16(f32x4 (&v)[4], const float* g, const float* b, int lane) {
    float s = 0.f;
#pragma unroll
    for (int j = 0; j < 4; ++j) s += (v[j].x + v[j].y) + (v[j].z + v[j].w);
    const float mean = wave_sum(s) * (1.f / D); float s2 = 0.f;
#pragma unroll
    for (int j = 0; j < 4; ++j) { v[j] = v[j] - mean; s2 += (v[j].x * v[j].x + v[j].y * v[j].y) + (v[j].z * v[j].z + v[j].w * v[j].w); }
    const float rstd = 1.f / sqrtf(wave_sum(s2) * (1.f / D) + LN_EPS);
#pragma unroll
    for (int j = 0; j < 4; ++j) { const f32x4 gv = *(const f32x4*)(g + 4 * lane + 256 * j), bv = *(const f32x4*)(b + 4 * lane + 256 * j); v[j] = v[j] * rstd * gv + bv; }
}
__device__ __forceinline__ void store_row(const f32x4 (&v)[4], float* hrow, bf16* brow, int lane) {
#pragma unroll
    for (int j = 0; j < 4; ++j) { *(f32x4*)(hrow + 4 * lane + 256 * j) = v[j]; v2u w; w.x = cvt_pk_bf16(v[j].x, v[j].y); w.y = cvt_pk_bf16(v[j].z, v[j].w); *(v2u*)(brow + 4 * lane + 256 * j) = w; }
}

__device__ __forceinline__ void phase_prologue(Frame& F, CArgs a) {
    LAS float* scr = (LAS float*)(F.lds + RING_OFF + F.wave * 16384);
    const int gw = F.wg * NWAVES + F.wave, NGW = F.G * NWAVES;
    constexpr int I_INS = 16 * 64, I_G = 16 * 128, I_B = 3 * 4 * 32, I_O = 16 * 32, I_GU = NE * 16 * 64, I_D = NE * 16 * 32, I_TOT = I_INS + I_G + I_B + I_O + I_GU + I_D;
    for (int it = gw; it < DEPTH * I_TOT; it += NGW) {
        const int l = it / I_TOT; int r = it - l * I_TOT; unsigned char* wl = a->ws + WS_W0 + (size_t)l * W_LAYER;
        if (r < I_INS) { transpose_item(a->in[3] + (size_t)l * D * IN_COLS, IN_COLS, (bf16*)(wl + WO_INS), D, RmId(), scr, r / 64, r % 64, F.lane); continue; } r -= I_INS;
        if (r < I_G) { transpose_item(a->in[3] + (size_t)l * D * IN_COLS + 2048, IN_COLS, (bf16*)(wl + WO_G), D, RmGate(), scr, r / 128, r % 128, F.lane); continue; } r -= I_G;
        if (r < I_B) { const int g = r / 128, rr = r % 128; transpose_item(a->in[14] + (size_t)(l * 4 + g) * 256 * D, D, (bf16*)(wl + WO_B) + (size_t)g * D * 256, 256, RmId(), scr, rr / 32, rr % 32, F.lane); continue; } r -= I_B;
        if (r < I_O) { transpose_item(a->in[15] + (size_t)l * D * D, D, (bf16*)(wl + WO_O), D, RmId(), scr, r / 32, r % 32, F.lane); continue; } r -= I_O;
        if (r < I_GU) { const int e = r / 1024, rr = r % 1024; transpose_item8(a->in[20] + (size_t)(l * NE + e) * D * 2048, 2048, (unsigned char*)(wl + WO_GU) + (size_t)e * 2048 * D, D, RmGlu(), scr, rr / 64, rr % 64, F.lane, pg8::W1_SCALE); continue; } r -= I_GU;
        { const int e = r / 512, rr = r % 512; transpose_item8(a->in[22] + (size_t)(l * NE + e) * D * D, D, (unsigned char*)(wl + WO_D) + (size_t)e * D * D, D, RmId(), scr, rr / 32, rr % 32, F.lane, pg8::W2_SCALE); }
    }
    const int gt = F.wg * (NWAVES * 64) + F.tid, NT_ = F.G * NWAVES * 64;
    for (int o = gt; o < DEPTH * 262144; o += NT_) {
        const int l = o >> 18, r = o & 262143, d = r >> 8, k = r & 255, grp = k >> 6, c = k & 63;
        const float* pw = a->in[12] + ((size_t)(l * 4 + grp) * 64 + c) * 64; const float* ps = a->in[13] + l * 256 + grp * 64; const float* wb = a->in[14] + ((size_t)(l * 4 + 3) * 256 + grp * 64) * D + d;
        float s = 0.f;
        for (int d2 = 0; d2 < 64; ++d2) s += pw[d2] * ps[d2] * wb[(size_t)d2 * D];
        ((bf16*)(a->ws + WS_W0 + (size_t)l * W_LAYER + WO_B))[(size_t)3 * D * 256 + (size_t)d * 256 + k] = (bf16)(cvt_pk_bf16(s, 0.f) & 0xffffu);
    }
    for (int i = gt; i < 192 * 16; i += NT_) { const int p = i >> 4, fi = i & 15, pp = p < 128 ? p : p - 128;
        double th = (fi & 3) == 0 ? 1.0 : (fi & 3) == 1 ? 0.5623413251903491 : (fi & 3) == 2 ? 0.31622776601683794 : 0.1778279410038923;
        for (int k = 0; k < (fi >> 2); ++k) th *= 0.1;
        const double t2 = th * th; double c = 1.0, s = th, tc = 1.0, tsn = th;
        for (int k = 1; k <= 12; ++k) { tc *= -t2 / (double)((2 * k - 1) * (2 * k)); tsn *= -t2 / (double)((2 * k) * (2 * k + 1)); c += tc; s += tsn; }
        double rc = 1.0, rs = 0.0, bc = c, bs = s;
        for (int n = pp; n > 0; n >>= 1) { if (n & 1) { const double t = rc * bc - rs * bs; rs = rc * bs + rs * bc; rc = t; } const double t = bc * bc - bs * bs; bs = 2.0 * bc * bs; bc = t; }
        float* rope = (float*)(a->ws + WS_ROPE); rope[p * 32 + fi] = (float)rc; rope[p * 32 + 16 + fi] = (float)rs; }
    for (int m = gw; m < M; m += NGW) { f32x4 v[4];
#pragma unroll
        for (int j = 0; j < 4; ++j) v[j] = *(const f32x4*)(a->in[0] + (size_t)m * D + 4 * F.lane + 256 * j);
        ln16(v, a->in[1], a->in[2], F.lane); store_row(v, a->out + (size_t)m * D, (bf16*)(a->ws + WS_HB) + (size_t)m * D, F.lane); }
}

__device__ __forceinline__ void phase_prep(Frame& F, CArgs a, int l) {
    const bf16* zs = (const bf16*)(a->ws + WS_ZS); bf16* qn = (bf16*)(a->ws + WS_QN); bf16* kn = (bf16*)(a->ws + WS_KN); bf16* br = (bf16*)(a->ws + WS_BR);
    {
        LAS float* sbuf = (LAS float*)(F.lds + RING_OFF);
        LAS float* ybuf = (LAS float*)(F.lds + RING_OFF + 65536);
        const float* cw = a->in[8] + l * 31 * 256; const float* lg = a->in[10] + l * 256; const float* lb = a->in[11] + l * 256;
        const int c = F.tid & 255, hf = F.tid >> 8;
        float w[31];
#pragma unroll
        for (int j = 0; j < 31; ++j) w[j] = cw[j * 256 + c];
        const float cbias = a->in[9][l * 256 + c];
        for (int it = F.wg; it < M / 32; it += F.G) {
            const int tok0 = it * 32, p0 = tok0 & (SEQ - 1); const bf16* zb = zs + (size_t)(tok0 - p0) * ZSW;
            for (int task = F.tid; task < 62 * 32; task += NWAVES * 64) {
                const int rr = task >> 5, ck = task & 31, p = p0 - 15 + rr; f32x4 o0 = (f32x4){0.f, 0.f, 0.f, 0.f}, o1 = o0;
                if (p >= 0 && p < SEQ) { float av[8], gv[8]; unpack8(*(const GAS v4u*)(zb + (size_t)p * ZSW + 1280 + ck * 8), av); unpack8(*(const GAS v4u*)(zb + (size_t)p * ZSW + 1536 + ck * 8), gv);
                    o0 = (f32x4){av[0] * sigm(gv[0]), av[1] * sigm(gv[1]), av[2] * sigm(gv[2]), av[3] * sigm(gv[3])}; o1 = (f32x4){av[4] * sigm(gv[4]), av[5] * sigm(gv[5]), av[6] * sigm(gv[6]), av[7] * sigm(gv[7])}; }
                *(LAS f32x4*)(sbuf + rr * 256 + ck * 8) = o0; *(LAS f32x4*)(sbuf + rr * 256 + ck * 8 + 4) = o1;
            }
            __syncthreads();
            float acc[16];
#pragma unroll
            for (int i = 0; i < 16; ++i) acc[i] = 0.f;
#pragma unroll
            for (int j = 0; j < 46; ++j) { const float v = sbuf[(hf * 16 + j) * 256 + c];
#pragma unroll
                for (int i = 0; i < 16; ++i) { if (j - i >= 0 && j - i < 31) acc[i] += w[j - i] * v; } }
#pragma unroll
            for (int i = 0; i < 16; ++i) ybuf[(hf * 16 + i) * 256 + c] = acc[i] + cbias;
            __syncthreads();
#pragma unroll
            for (int q = 0; q < 4; ++q) { const int t = F.wave * 4 + q; f32x4 y = *(const LAS f32x4*)(ybuf + t * 256 + 4 * F.lane);
                const float mean = wave_sum((y.x + y.y) + (y.z + y.w)) * (1.f / 256.f); y = y - mean;
                const float rstd = 1.f / sqrtf(wave_sum((y.x * y.x + y.y * y.y) + (y.z * y.z + y.w * y.w)) * (1.f / 256.f) + LN_EPS);
                const f32x4 o = y * rstd * *(const f32x4*)(lg + 4 * F.lane) + *(const f32x4*)(lb + 4 * F.lane);
                v2u wv; wv.x = cvt_pk_bf16(o.x * sigm(o.x), o.y * sigm(o.y)); wv.y = cvt_pk_bf16(o.z * sigm(o.z), o.w * sigm(o.w));
                *(GAS v2u*)(br + (size_t)(tok0 + t) * 1024 + 512 + 4 * F.lane) = wv; }
            __syncthreads();
        }
    }
    const int gt = F.wg * (NWAVES * 64) + F.tid, NT_ = F.G * NWAVES * 64;
    {
        const float* qg = a->in[5] + l * 64; const float* kg = a->in[6] + l * 64; const float* rope = (const float*)(a->ws + WS_ROPE);
        for (int it = gt; it < M * 6; it += NT_) {
            const int tok = it / 6, hh = it - tok * 6; const bf16* src = zs + (size_t)tok * ZSW + hh * 64;
            float x[64]; float ss = 0.f;
#pragma unroll
            for (int q = 0; q < 8; ++q) { float t8[8]; unpack8(*(const GAS v4u*)(src + q * 8), t8);
#pragma unroll
                for (int i = 0; i < 8; ++i) { x[q * 8 + i] = t8[i]; ss += t8[i] * t8[i]; } }
            const float rinv = 1.f / sqrtf(ss * (1.f / 64.f) + RMS_EPS); const float* gn = hh < 4 ? qg : kg; const float sc = hh < 4 ? QSCALE : 1.f;
#pragma unroll
            for (int i = 0; i < 64; ++i) x[i] *= rinv * gn[i] * sc;
            const int pos = tok & (SEQ - 1); const float* tr = rope + (pos >> 6) * 32; const float* tc = rope + (128 + (pos & 63)) * 32;
            float o[64];
#pragma unroll
            for (int i = 0; i < 16; ++i) { const float cr = tr[i], sr = tr[16 + i], cc = tc[i], sn = tc[16 + i];
                o[i] = x[i] * cr - x[16 + i] * sr; o[16 + i] = x[16 + i] * cr + x[i] * sr; o[32 + i] = x[32 + i] * cc - x[48 + i] * sn; o[48 + i] = x[48 + i] * cc + x[32 + i] * sn; }
            bf16* dst = hh < 4 ? qn + (size_t)tok * 256 + hh * 64 : kn + (size_t)tok * 128 + (hh - 4) * 64;
#pragma unroll
            for (int q = 0; q < 8; ++q) { float t8[8];
#pragma unroll
                for (int i = 0; i < 8; ++i) t8[i] = o[q * 8 + i];
                *(GAS v4u*)(dst + q * 8) = pack8(t8); }
        }
    }
    {
        const float* scw = a->in[7] + l * 3 * 256;
        for (int it = gt; it < M * 32; it += NT_) {
            const int tok = it >> 5, ch = (it & 31) * 8, pos = tok & (SEQ - 1); float acc[8];
#pragma unroll
            for (int i = 0; i < 8; ++i) acc[i] = 0.f;
#pragma unroll
            for (int j = -1; j <= 1; ++j) { const int p = pos + j;
                if (p >= 0 && p < SEQ) { float cg[8], u[8]; unpack8(*(const GAS v4u*)(zs + (size_t)(tok + j) * ZSW + 768 + ch), cg); unpack8(*(const GAS v4u*)(zs + (size_t)(tok + j) * ZSW + 1024 + ch), u);
#pragma unroll
                    for (int i = 0; i < 8; ++i) acc[i] += scw[(j + 1) * 256 + ch + i] * (cg[i] * u[i]); } }
            float bg[8]; unpack8(*(const GAS v4u*)(zs + (size_t)tok * ZSW + 512 + ch), bg);
#pragma unroll
            for (int i = 0; i < 8; ++i) acc[i] *= bg[i];
            *(GAS v4u*)(br + (size_t)tok * 1024 + 256 + ch) = pack8(acc);
        }
    }
    {
        for (int it = gt; it < M * 32; it += NT_) {
            const int tok = it >> 5, ch = (it & 31) * 8, pos = tok & (SEQ - 1), grp = ch >> 6, w = 2 << grp;
            const int lo = (pos - (w >> 1)) > 0 ? (pos - (w >> 1)) : 0, hi = (pos + (w - 1 - (w >> 1))) < (SEQ - 1) ? (pos + (w - 1 - (w >> 1))) : (SEQ - 1);
            float s[8];
#pragma unroll
            for (int i = 0; i < 8; ++i) s[i] = 0.f;
            for (int p = lo; p <= hi; ++p) { float u[8]; unpack8(*(const GAS v4u*)(zs + (size_t)(tok - pos + p) * ZSW + 1792 + ch), u);
#pragma unroll
                for (int i = 0; i < 8; ++i) s[i] += u[i]; }
            const float inv = 1.f / (float)(hi - lo + 1); float uc[8]; unpack8(*(const GAS v4u*)(zs + (size_t)tok * ZSW + 1792 + ch), uc);
#pragma unroll
            for (int i = 0; i < 8; ++i) s[i] = s[i] * inv - uc[i];
            *(GAS v4u*)(br + (size_t)tok * 1024 + 768 + ch) = pack8(s);
        }
    }
}

__device__ __forceinline__ void phase_ln_router(Frame& F, CArgs a, int l, int cs) {
    LAS float* wrT = (LAS float*)(F.lds + RING_OFF);
    LAS unsigned* hist = (LAS unsigned*)(F.lds + HIST_OFF); LAS float* lgs = (LAS float*)(F.lds + LG_OFF) + F.wave * 64;
    const float* wr = a->in[18] + (size_t)l * D * NE; const float* brt = a->in[19] + l * NE;
    for (int idx = F.tid; idx < NE * D; idx += NWAVES * 64) { const int e = idx >> 10, d = idx & 1023; wrT[idx] = wr[d * NE + e]; }
    if (F.tid < NE) hist[F.tid] = 0u;
    __syncthreads();
    const float* Y1 = (const float*)(a->ws + WS_Y1); float* H = (float*)(a->ws + WS_H1); bf16* hb = (bf16*)(a->ws + WS_HB); int* topE = (int*)(a->ws + WS_TOPE); float* topW = (float*)(a->ws + WS_TOPW); int* topR = (int*)(a->ws + WS_TOPR);
    const float* g1 = a->in[16] + l * D; const float* b1 = a->in[17] + l * D;
    const int TPW = M / F.G, tok_lo = F.wg * TPW;
    for (int r0 = F.wave * 2; r0 < TPW; r0 += NWAVES * 2) {
        const int tokA = tok_lo + r0;
        f32x4 v[2][4];
#pragma unroll
        for (int rr = 0; rr < 2; ++rr) {
#pragma unroll
            for (int j = 0; j < 4; ++j) v[rr][j] = *(const f32x4*)(Y1 + (size_t)(tokA + rr) * D + 4 * F.lane + 256 * j);
            ln16(v[rr], g1, b1, F.lane); store_row(v[rr], H + (size_t)(tokA + rr) * D, hb + (size_t)(tokA + rr) * D, F.lane); }
        float p0[32], p1[32];
#pragma unroll
        for (int e = 0; e < 32; ++e) { float s0 = 0.f, s1 = 0.f;
#pragma unroll
            for (int j = 0; j < 4; ++j) { const f32x4 w4 = *(const LAS f32x4*)(wrT + e * 1024 + 256 * j + 4 * F.lane);
                s0 += (v[0][j].x * w4.x + v[0][j].y * w4.y) + (v[0][j].z * w4.z + v[0][j].w * w4.w); s1 += (v[1][j].x * w4.x + v[1][j].y * w4.y) + (v[1][j].z * w4.z + v[1][j].w * w4.w); }
            p0[e] = s0; p1[e] = s1; }
#define RT_STEP(OFF, HALFN) { const bool up = (F.lane & (OFF)) != 0; _Pragma("unroll") for (int i = 0; i < (HALFN); ++i) { \
            const float k0 = up ? p0[i + (HALFN)] : p0[i], s0 = up ? p0[i] : p0[i + (HALFN)]; p0[i] = k0 + __shfl_xor(s0, (OFF)); \
            const float k1 = up ? p1[i + (HALFN)] : p1[i], s1 = up ? p1[i] : p1[i + (HALFN)]; p1[i] = k1 + __shfl_xor(s1, (OFF)); } }
        RT_STEP(32, 16) RT_STEP(16, 8) RT_STEP(8, 4) RT_STEP(4, 2) RT_STEP(2, 1)
#undef RT_STEP
        const int le = F.lane >> 1; const float be = brt[le];
        const float lgA = p0[0] + __shfl_xor(p0[0], 1) + be, lgB = p1[0] + __shfl_xor(p1[0], 1) + be;
        if ((F.lane & 1) == 0) { lgs[le] = lgA; lgs[32 + le] = lgB; }
        LDS_WAIT(); asm volatile("" ::: "memory");
        const int rsel = F.lane >> 5; const LAS float* lr = lgs + rsel * 32;
        float v0 = -INFINITY, v1 = -INFINITY, v2 = -INFINITY, v3 = -INFINITY; int i0 = 0, i1 = 0, i2 = 0, i3 = 0;
#pragma unroll
        for (int e = 0; e < 32; ++e) { const float x = lr[e];
            if (x > v3) { if (x > v0) { v3 = v2; i3 = i2; v2 = v1; i2 = i1; v1 = v0; i1 = i0; v0 = x; i0 = e; }
                          else if (x > v1) { v3 = v2; i3 = i2; v2 = v1; i2 = i1; v1 = x; i1 = e; }
                          else if (x > v2) { v3 = v2; i3 = i2; v2 = x; i2 = e; }
                          else { v3 = x; i3 = e; } } }
        LDS_WAIT(); asm volatile("" ::: "memory");
        if ((F.lane & 31) == 0) {
            const float e1 = __expf(v1 - v0), e2 = __expf(v2 - v0), e3 = __expf(v3 - v0), inv = 1.f / (1.f + e1 + e2 + e3); const int tok = tokA + rsel;
            const unsigned k0 = __hip_atomic_fetch_add(hist + i0, 1u, __ATOMIC_RELAXED, __HIP_MEMORY_SCOPE_WORKGROUP), k1 = __hip_atomic_fetch_add(hist + i1, 1u, __ATOMIC_RELAXED, __HIP_MEMORY_SCOPE_WORKGROUP);
            const unsigned k2 = __hip_atomic_fetch_add(hist + i2, 1u, __ATOMIC_RELAXED, __HIP_MEMORY_SCOPE_WORKGROUP), k3 = __hip_atomic_fetch_add(hist + i3, 1u, __ATOMIC_RELAXED, __HIP_MEMORY_SCOPE_WORKGROUP);
            *(int4*)(topE + tok * 4) = make_int4(i0, i1, i2, i3); *(float4*)(topW + tok * 4) = make_float4(inv, e1 * inv, e2 * inv, e3 * inv); *(int4*)(topR + tok * 4) = make_int4((int)k0, (int)k1, (int)k2, (int)k3);
        }
    }
    __syncthreads();
    if (F.tid < NE) { const unsigned base = __hip_atomic_fetch_add(F.ctl + CW_CNT + 64 * l + 32 * cs + F.tid, hist[F.tid], RLX_AGENT); ((int*)(a->ws + WS_WGB))[F.wg * NE + F.tid] = (int)base; }
}
__device__ __forceinline__ void phase_router2(Frame& F, CArgs a, int l, int cs) {
    LAS v4u* wf = (LAS v4u*)(F.lds + RING_OFF);
    LAS float* g1s = (LAS float*)(F.lds + RING_OFF + 65536); LAS float* b1s = g1s + 1024;
    LAS float* lg = (LAS float*)(F.lds + RING_OFF + 73728) + F.wave * (16 * 33);
    LAS unsigned* hist = (LAS unsigned*)(F.lds + HIST_OFF);
    const float* wr = a->in[18] + (size_t)l * D * NE; const float* brt = a->in[19] + l * NE;
    const float* g1 = a->in[16] + l * D; const float* b1 = a->in[17] + l * D;
    for (int f = F.tid; f < 16 * 2 * 2 * 64; f += NWAVES * 64) { const int ln = f & 63, mf = (f >> 6) & 1, nb = (f >> 7) & 1, ds = f >> 8;
        const float* src = wr + (size_t)(64 * ds + 16 * (ln >> 4) + 8 * mf) * NE + 16 * nb + (ln & 15);
        v4u o; o.x = cvt_pk_bf16(src[0], src[NE]); o.y = cvt_pk_bf16(src[2 * NE], src[3 * NE]); o.z = cvt_pk_bf16(src[4 * NE], src[5 * NE]); o.w = cvt_pk_bf16(src[6 * NE], src[7 * NE]); wf[f] = o; }
    for (int k = F.tid; k < D; k += NWAVES * 64) { g1s[k] = g1[k]; b1s[k] = b1[k]; }
    if (F.tid < NE) hist[F.tid] = 0u;
    __syncthreads();
    const float* Y1 = (const float*)(a->ws + WS_Y1); unsigned char* X8 = (unsigned char*)(a->ws + WS_X8);
    int* topE = (int*)(a->ws + WS_TOPE); float* topW = (float*)(a->ws + WS_TOPW); int* topR = (int*)(a->ws + WS_TOPR);
    const int TPW = M / F.G, tok_lo = F.wg * TPW, i = F.lane & 15, q = F.lane >> 4;
    const float be0 = brt[i], be1 = brt[16 + i];
    for (int blk = F.wave; blk < TPW / 16; blk += NWAVES) {
        const int tok0 = tok_lo + blk * 16;
        const float* yrow = Y1 + (size_t)(tok0 + i) * D + 16 * q; unsigned char* xrow = X8 + (size_t)(tok0 + i) * D + 16 * q;
        float s = 0.f, ss = 0.f;
#pragma unroll 4
        for (int ds = 0; ds < 16; ++ds) {
#pragma unroll
            for (int c = 0; c < 4; ++c) { const f32x4 y = *(const f32x4*)(yrow + 64 * ds + 4 * c); s += (y.x + y.y) + (y.z + y.w); ss += (y.x * y.x + y.y * y.y) + (y.z * y.z + y.w * y.w); } }
        s += __shfl_xor(s, 16); s += __shfl_xor(s, 32); ss += __shfl_xor(ss, 16); ss += __shfl_xor(ss, 32);
        const float mean = s * (1.f / D), var = fmaxf(ss * (1.f / D) - mean * mean, 0.f), rstd = 1.f / sqrtf(var + LN_EPS);
        f32x4 acc0 = (f32x4){0.f, 0.f, 0.f, 0.f}, acc1 = acc0;
#pragma unroll 2
        for (int ds = 0; ds < 16; ++ds) {
            float h[16];
#pragma unroll
            for (int c = 0; c < 4; ++c) { const f32x4 y = *(const f32x4*)(yrow + 64 * ds + 4 * c); const f32x4 gv = *(const LAS f32x4*)(g1s + 64 * ds + 16 * q + 4 * c), bv = *(const LAS f32x4*)(b1s + 64 * ds + 16 * q + 4 * c);
                const f32x4 hv = (y - mean) * rstd * gv + bv; h[4 * c] = hv.x; h[4 * c + 1] = hv.y; h[4 * c + 2] = hv.z; h[4 * c + 3] = hv.w; }
            v4u a0, a1, x8;
            a0.x = cvt_pk_bf16(h[0], h[1]); a0.y = cvt_pk_bf16(h[2], h[3]); a0.z = cvt_pk_bf16(h[4], h[5]); a0.w = cvt_pk_bf16(h[6], h[7]);
            a1.x = cvt_pk_bf16(h[8], h[9]); a1.y = cvt_pk_bf16(h[10], h[11]); a1.z = cvt_pk_bf16(h[12], h[13]); a1.w = cvt_pk_bf16(h[14], h[15]);
            x8.x = pg8::pk4_fp8(h[0], h[1], h[2], h[3]); x8.y = pg8::pk4_fp8(h[4], h[5], h[6], h[7]); x8.z = pg8::pk4_fp8(h[8], h[9], h[10], h[11]); x8.w = pg8::pk4_fp8(h[12], h[13], h[14], h[15]);
            *(GAS v4u*)(xrow + 64 * ds) = x8;
            const LAS v4u* wp = wf + ds * 256 + F.lane;
            const pg8::bf16x8 fa0 = __builtin_bit_cast(pg8::bf16x8, a0), fa1 = __builtin_bit_cast(pg8::bf16x8, a1);
            acc0 = __builtin_amdgcn_mfma_f32_16x16x32_bf16(fa0, __builtin_bit_cast(pg8::bf16x8, wp[0]), acc0, 0, 0, 0);
            acc0 = __builtin_amdgcn_mfma_f32_16x16x32_bf16(fa1, __builtin_bit_cast(pg8::bf16x8, wp[64]), acc0, 0, 0, 0);
            acc1 = __builtin_amdgcn_mfma_f32_16x16x32_bf16(fa0, __builtin_bit_cast(pg8::bf16x8, wp[128]), acc1, 0, 0, 0);
            acc1 = __builtin_amdgcn_mfma_f32_16x16x32_bf16(fa1, __builtin_bit_cast(pg8::bf16x8, wp[192]), acc1, 0, 0, 0);
        }
#pragma unroll
        for (int r = 0; r < 4; ++r) { lg[(4 * q + r) * 33 + i] = acc0[r] + be0; lg[(4 * q + r) * 33 + 16 + i] = acc1[r] + be1; }
        LDS_WAIT(); asm volatile("" ::: "memory");
        const LAS float* lr = lg + i * 33;
        float v0 = -INFINITY, v1 = -INFINITY, v2 = -INFINITY, v3 = -INFINITY; int i0 = 0, i1 = 0, i2 = 0, i3 = 0;
#pragma unroll
        for (int e = 0; e < 32; ++e) { const float x = lr[e];
            if (x > v3) { if (x > v0) { v3 = v2; i3 = i2; v2 = v1; i2 = i1; v1 = v0; i1 = i0; v0 = x; i0 = e; }
                          else if (x > v1) { v3 = v2; i3 = i2; v2 = v1; i2 = i1; v1 = x; i1 = e; }
                          else if (x > v2) { v3 = v2; i3 = i2; v2 = x; i2 = e; }
                          else { v3 = x; i3 = e; } } }
        LDS_WAIT(); asm volatile("" ::: "memory");
        if (F.lane < 16) {
            const float e1 = __expf(v1 - v0), e2 = __expf(v2 - v0), e3 = __expf(v3 - v0), inv = 1.f / (1.f + e1 + e2 + e3); const int tok = tok0 + i;
            const unsigned k0 = __hip_atomic_fetch_add(hist + i0, 1u, __ATOMIC_RELAXED, __HIP_MEMORY_SCOPE_WORKGROUP), k1 = __hip_atomic_fetch_add(hist + i1, 1u, __ATOMIC_RELAXED, __HIP_MEMORY_SCOPE_WORKGROUP);
            const unsigned k2 = __hip_atomic_fetch_add(hist + i2, 1u, __ATOMIC_RELAXED, __HIP_MEMORY_SCOPE_WORKGROUP), k3 = __hip_atomic_fetch_add(hist + i3, 1u, __ATOMIC_RELAXED, __HIP_MEMORY_SCOPE_WORKGROUP);
            *(int4*)(topE + tok * 4) = make_int4(i0, i1, i2, i3); *(float4*)(topW + tok * 4) = make_float4(inv, e1 * inv, e2 * inv, e3 * inv); *(int4*)(topR + tok * 4) = make_int4((int)k0, (int)k1, (int)k2, (int)k3);
        }
    }
    __syncthreads();
    if (F.tid < NE) { const unsigned base = __hip_atomic_fetch_add(F.ctl + CW_CNT + 64 * l + 32 * cs + F.tid, hist[F.tid], RLX_AGENT); ((int*)(a->ws + WS_WGB))[F.wg * NE + F.tid] = (int)base; }
}
__device__ __forceinline__ void build_moe_tab(Frame& F, int l, int nct) {
    LAS int* tab = (LAS int*)(F.lds + TAB_OFF);
    if (F.tid == 0) { int cu = 0, ts = 0;
        for (int e = 0; e < NE; ++e) { const int cnt = (int)__hip_atomic_load(F.ctl + CW_CNT + 64 * l + 32 * ((REP_MASK >> 6) & 1) + e, RLX_AGENT), nt = (cnt + 255) >> 8; tab[e] = cu; tab[33 + e] = ts; cu += nt * nct; ts += nt; }
        tab[32] = cu; tab[65] = ts; }
    __syncthreads();
}
__device__ __forceinline__ void phase_scatter(Frame& F, CArgs a, int l) {
    build_moe_tab(F, l, 8);
    const LAS int* tab = (const LAS int*)(F.lds + TAB_OFF);
    const unsigned char* X8 = (const unsigned char*)(a->ws + WS_X8); unsigned char* xs = (unsigned char*)(a->ws + WS_XS); const int* topE = (const int*)(a->ws + WS_TOPE); const int* topR = (const int*)(a->ws + WS_TOPR); int* topP = (int*)(a->ws + WS_TOPP); const int* wgb = (const int*)(a->ws + WS_WGB) + F.wg * NE;
    const int TPW = M / F.G, tok_lo = F.wg * TPW;
    for (int r = F.wave * 2; r < TPW; r += NWAVES * 2) {
        const int tok = tok_lo + r; int pos = 0;
        if (F.lane < 8) { const int e = topE[tok * 4 + F.lane]; pos = tab[33 + e] * 256 + wgb[e] + topR[tok * 4 + F.lane]; }
        const v4u xa = *(const GAS v4u*)(X8 + (size_t)tok * D + 16 * F.lane), xb = *(const GAS v4u*)(X8 + (size_t)(tok + 1) * D + 16 * F.lane);
#pragma unroll
        for (int k = 0; k < 4; ++k) { const int pa = __shfl(pos, k), pb = __shfl(pos, 4 + k); *(GAS v4u*)(xs + (size_t)pa * D + 16 * F.lane) = xa; *(GAS v4u*)(xs + (size_t)pb * D + 16 * F.lane) = xb; }
        if (F.lane < 8) topP[tok * 4 + F.lane] = pos;
    }
}
__device__ __forceinline__ void phase_combine(Frame& F, CArgs a, int l) {
    const float* Y1 = (const float*)(a->ws + WS_Y1); float* H = a->out; bf16* hb = (bf16*)(a->ws + WS_HB); const bf16* Y = (const bf16*)(a->ws + WS_Y); const float* topW = (const float*)(a->ws + WS_TOPW); const int* topP = (const int*)(a->ws + WS_TOPP);
    const float* g1 = a->in[16] + l * D; const float* b1 = a->in[17] + l * D; const float* g2 = a->in[24] + l * D; const float* b2 = a->in[25] + l * D;
    const int gw = F.wg * NWAVES + F.wave, NGW = F.G * NWAVES;
    for (int tok = gw * 2; tok < M; tok += NGW * 2) {
        int4 ps[2]; float4 ws[2]; f32x4 v[2][4]; v2u y[2][4][4];
#pragma unroll
        for (int u = 0; u < 2; ++u) { ps[u] = *(const int4*)(topP + (tok + u) * 4); ws[u] = *(const float4*)(topW + (tok + u) * 4); }
#pragma unroll
        for (int u = 0; u < 2; ++u)
#pragma unroll
            for (int j = 0; j < 4; ++j) v[u][j] = *(const f32x4*)(Y1 + (size_t)(tok + u) * D + 4 * F.lane + 256 * j);
#pragma unroll
        for (int u = 0; u < 2; ++u) { const int pk[4] = {ps[u].x, ps[u].y, ps[u].z, ps[u].w};
#pragma unroll
            for (int k = 0; k < 4; ++k)
#pragma unroll
                for (int j = 0; j < 4; ++j) y[u][k][j] = *(const GAS v2u*)(Y + (size_t)pk[k] * D + 4 * F.lane + 256 * j); }
#pragma unroll
        for (int u = 0; u < 2; ++u) { const float wk[4] = {ws[u].x, ws[u].y, ws[u].z, ws[u].w};
            ln16(v[u], g1, b1, F.lane);
#pragma unroll
            for (int j = 0; j < 4; ++j) { v[u][j] = v[u][j] * DN_ALPHA;
#pragma unroll
                for (int k = 0; k < 4; ++k) { const v2u yy = y[u][k][j]; v[u][j].x += wk[k] * bflo(yy.x); v[u][j].y += wk[k] * bfhi(yy.x); v[u][j].z += wk[k] * bflo(yy.y); v[u][j].w += wk[k] * bfhi(yy.y); } }
            ln16(v[u], g2, b2, F.lane); store_row(v[u], H + (size_t)(tok + u) * D, hb + (size_t)(tok + u) * D, F.lane); }
    }
}

__global__ void __launch_bounds__(NWAVES * 64, 2) mk_fwd(Args args) {
    extern __shared__ __attribute__((aligned(16))) unsigned char lds[];
    Frame F;
    F.lds = (LAS unsigned char*)lds; F.MISC = (volatile LAS unsigned*)(F.lds + MISC_OFF);
    F.tid = threadIdx.x; F.lane = F.tid & 63; F.wave = __builtin_amdgcn_readfirstlane(F.tid >> 6);
    F.G = gridDim.x; F.wg = blockIdx.x; { const int bx = blockIdx.x; F.vcu = (F.G % 8 == 0) ? (bx % 8) * (F.G / 8) + bx / 8 : bx; }
    CArgs ap = (CArgs)__builtin_amdgcn_kernarg_segment_ptr();
    F.ctl = (gu32*)(ap->ws + WS_CTL);
    for (int u = F.tid; u < (LDS_BYTES - LDSCTL_OFF) / 4; u += NWAVES * 64) ((LAS unsigned*)(F.lds + LDSCTL_OFF))[u] = 0u;
    __syncthreads();
#if MK_ONE_LAUNCH
    XcdBarrier bar = xcd_barrier_post((unsigned*)(F.ctl + CW_BAR), F.MISC + 8);
#define GRID_BAR() do { asm volatile("" : "+s"(bar.bar)); xcd_barrier(bar); } while (0)
#else
#define GRID_BAR() do { } while (0)
#endif
    const int lo = args.ph_lo, hi = args.ph_hi;
#ifndef PH_MASK
#define PH_MASK 0xfff
#endif
#define IN(k) (lo <= (k) && (k) < hi)
#define ON(s) (((PH_MASK) >> (s)) & 1)
#define REPEAT(s) _Pragma("unroll 1") for (int rep_ = 0; rep_ < 1 + (((REP_MASK) >> (s)) & 1); ++rep_)
#define FRESH() do { asm volatile("" : "+v"(F.tid), "+v"(F.lane)); asm volatile("" : "+s"(ap)); asm volatile("" : "+s"(F.wg)); asm volatile("" : "+s"(F.G)); asm volatile("" : "+s"(F.vcu)); } while (0)
#define SEAM(k) do { if (IN((k) + 1)) GRID_BAR(); } while (0)
#define WSP (ap->ws)
#define WLP (ap->ws + WS_W0 + (size_t)l * W_LAYER)
    REPEAT(11) if (ON(11) && IN(0)) { FRESH(); phase_prologue(F, ap); SEAM(0); }
#pragma unroll 1
    for (int l = 0; l < DEPTH; ++l) {
        const int pb = 1 + NSUB * l;
        REPEAT(0) if (ON(0) && IN(pb + 0)) { FRESH();
            pg8::Gemm g{(const pg8::bf16_t*)(WSP + WS_HB), (const pg8::bf16_t*)(WLP + WO_INS), M, ZSW, D, D, D}; pg8::StaticOrder S; S.init(M, ZSW, F.G, F.wg);
            pg8::EpiBf16<0> E{(pg8::bf16_t*)(WSP + WS_ZS), ZSW, ap->in[4] + l * IN_COLS, 0, 0, 1.f};
            pg8::gemm_phase<pg8::EpiBf16<0>, pg8::StaticOrder, true, true>(F.lds + RING_OFF, g, S, E); SEAM(pb + 0); }
        REPEAT(1) if (ON(1) && IN(pb + 1)) { FRESH(); phase_prep(F, ap, l); SEAM(pb + 1); }
        REPEAT(2) if (ON(2) && IN(pb + 2)) { FRESH();
            const attn_body::AttnTensors AT{(const attn_body::bf16*)(WSP + WS_QN), (const attn_body::bf16*)(WSP + WS_KN), (const attn_body::bf16*)(WSP + WS_ZS) + 384, (attn_body::bf16*)(WSP + WS_BR)};
            const attn_body::StaticOrder S(F.vcu);
            attn_body::attn_phase<attn_body::StaticOrder>((char*)lds + RING_OFF, AT, S); SEAM(pb + 2); }
        REPEAT(3) if (ON(3) && IN(pb + 3)) { FRESH();
            pg8::Gemm g{(const pg8::bf16_t*)(WSP + WS_BR), (const pg8::bf16_t*)(WLP + WO_B), M, 4096, 256, D, 256}; pg8::BranchOrder S; S.init(M, 4096, F.G, F.wg);
            pg8::EpiBf16<0> E{(pg8::bf16_t*)(WSP + WS_P), 4096, nullptr, 0, 0, 1.f};
            pg8::gemm_phase<pg8::EpiBf16<0>, pg8::BranchOrder, true, true>(F.lds + RING_OFF, g, S, E); SEAM(pb + 3); }
        REPEAT(4) if (ON(4) && IN(pb + 4)) { FRESH();
            pg8::Gemm g{(const pg8::bf16_t*)(WSP + WS_HB), (const pg8::bf16_t*)(WLP + WO_G), M, 4096, D, D, D}; pg8::StaticOrder S; S.init(M, 4096, F.G, F.wg);
            pg8::EpiGate E{(const pg8::bf16_t*)(WSP + WS_P), ap->in[4] + l * IN_COLS + 2048, (pg8::bf16_t*)(WSP + WS_MG)};
            pg8::gemm_phase<pg8::EpiGate, pg8::StaticOrder, true, true>(F.lds + RING_OFF, g, S, E); SEAM(pb + 4); }
        REPEAT(5) if (ON(5) && IN(pb + 5)) { FRESH();
            pg8::Gemm g{(const pg8::bf16_t*)(WSP + WS_MG), (const pg8::bf16_t*)(WLP + WO_O), M, D, D, D, D}; pg8::StaticOrder S; S.init(M, D, F.G, F.wg);
            pg8::EpiResid E{ap->out, (float*)(WSP + WS_Y1), DN_ALPHA};
            pg8::gemm_phase<pg8::EpiResid, pg8::StaticOrder, true, true>(F.lds + RING_OFF, g, S, E); SEAM(pb + 5); }
        REPEAT(6) if (ON(6) && IN(pb + 6)) { FRESH(); phase_router2(F, ap, l, rep_); SEAM(pb + 6); }
        REPEAT(7) if (ON(7) && IN(pb + 7)) { FRESH(); phase_scatter(F, ap, l); SEAM(pb + 7); }
        REPEAT(8) if (ON(8) && IN(pb + 8)) { FRESH();
            build_moe_tab(F, l, 8);
            pg8::Gemm g{(const pg8::bf16_t*)(WSP + WS_XS), (const pg8::bf16_t*)(WLP + WO_GU), RMAX, 2048 * NE, D, D, D}; pg8::MoeOrder S{(const LAS int*)(F.lds + TAB_OFF), 8, F.G, F.wg};
            pg8::EpiSwiglu E{(unsigned char*)(WSP + WS_HA), ap->in[21] + (size_t)l * NE * 2048};
            pg8::gemm_phase<pg8::EpiSwiglu, pg8::MoeOrder, true, true, true>(F.lds + RING_OFF, g, S, E); SEAM(pb + 8); }
        REPEAT(9) if (ON(9) && IN(pb + 9)) { FRESH();
            build_moe_tab(F, l, 4);
            pg8::Gemm g{(const pg8::bf16_t*)(WSP + WS_HA), (const pg8::bf16_t*)(WLP + WO_D), RMAX, D * NE, D, D, D}; pg8::MoeOrder S{(const LAS int*)(F.lds + TAB_OFF), 4, F.G, F.wg};
            pg8::EpiDown E{(pg8::bf16_t*)(WSP + WS_Y), ap->in[23] + (size_t)l * NE * D};
            pg8::gemm_phase<pg8::EpiDown, pg8::MoeOrder, true, true, true>(F.lds + RING_OFF, g, S, E); SEAM(pb + 9); }
        REPEAT(10) if (ON(10) && IN(pb + 10)) { FRESH(); phase_combine(F, ap, l); SEAM(pb + 10); }
    }
#undef IN
#undef SEAM
#undef WSP
#undef WLP
}

extern "C" void kernel_launch(void* const* d_in, const int* in_sizes, int n_in, void* d_out, int out_size, void* d_ws, size_t ws_size, hipStream_t stream) {
    static int grid = 0;
    if (grid == 0) {
        if (n_in != 26 || in_sizes[0] != M * D || out_size != M * D || ws_size < WS_END) { fprintf(stderr, "kernel_launch: unexpected shapes (n_in %d, in0 %d, out %d, ws %zu < %zu?); nothing launched\n", n_in, n_in > 0 ? in_sizes[0] : -1, out_size, ws_size, (size_t)WS_END); grid = -1; return; }
        if (hipFuncSetAttribute((const void*)mk_fwd, hipFuncAttributeMaxDynamicSharedMemorySize, LDS_BYTES) != hipSuccess) { fprintf(stderr, "kernel_launch: hipFuncSetAttribute failed\n"); grid = -1; return; }
        int per_cu = 0;
        if (hipOccupancyMaxActiveBlocksPerMultiprocessor(&per_cu, (const void*)mk_fwd, NWAVES * 64, LDS_BYTES) != hipSuccess || per_cu < 1) fprintf(stderr, "kernel_launch: note: occupancy query reports %d workgroups per CU\n", per_cu);
        (void)hipGetLastError();
        grid = 256;
    }
    if (grid < 0) return;
    if (hipMemsetAsync((char*)d_ws + WS_CTL, 0, CTL_ZERO_BYTES, stream) != hipSuccess) { fprintf(stderr, "kernel_launch: memset failed\n"); return; }
    Args a{};
    for (int i = 0; i < 26; ++i) a.in[i] = (const float*)d_in[i];
    a.out = (float*)d_out; a.ws = (unsigned char*)d_ws;
#if MK_ONE_LAUNCH
    a.ph_lo = 0; a.ph_hi = NPH;
    hipLaunchKernelGGL(mk_fwd, dim3(grid), dim3(NWAVES * 64), LDS_BYTES, stream, a);
#else
    for (int p = 0; p < NPH; ++p) { a.ph_lo = p; a.ph_hi = p + 1; hipLaunchKernelGGL(mk_fwd, dim3(grid), dim3(NWAVES * 64), LDS_BYTES, stream, a); }
#endif
    const hipError_t le = hipPeekAtLastError();
    if (le != hipSuccess) fprintf(stderr, "kernel_launch: launch failed: %s\n", hipGetErrorName(le));
}
```
